# Optimizing an MI355X kernel written in HIP

```python
import jax, jax.numpy as jnp
from jax import lax
import numpy as np

D_MODEL = 2048
BATCH = 8
SEQ = 2048
DEPTH = 4
DEC_BATCH = 16
DEC_SEQ = 2048
PAST_LEN = 128

GRID_W = 64
N_MIXERS = 4
MEM_TOKENS = 256
NORM_EPS = 1e-6
Q_BLOCK = 128

RET_HEADS = 8
RET_DK = D_MODEL // RET_HEADS
RET_DV = 2 * RET_DK
RET_CHUNK = 128
RET_ROPE_BASE = 10000.0
HG_HEADS = 16
HG_DK = 128
HG_DV = D_MODEL // HG_HEADS
HG_CHUNK = 32
MLA_HEADS = 16
MLA_Q_RANK = 512
MLA_KV_RANK = 512
MLA_NOPE = 128
MLA_ROPE = 64
MLA_V = 128
MLA_ROPE_BASE = 10000.0
GQA_HEADS = 16
GQA_KV_HEADS = 4
GQA_HD = 128
GQA_ROPE_BASE = 10000.0
MEM_HEADS = 4
MEM_HD = 128
D_FF = 4 * D_MODEL

N_RET = (DEPTH + N_MIXERS - 1) // N_MIXERS
N_HG = (DEPTH + N_MIXERS - 2) // N_MIXERS
N_MLA = (DEPTH + N_MIXERS - 3) // N_MIXERS
N_GQA = (DEPTH + N_MIXERS - 4) // N_MIXERS

kernel_name = 'hybrid_bidir_encoder_ret_hgrn2_mla_gqa'


def rmsnorm(x, g):
    xf = x.astype(jnp.float32)
    y = xf * lax.rsqrt(jnp.mean(xf * xf, axis=-1, keepdims=True) + NORM_EPS)
    return (y * g.astype(jnp.float32)).astype(x.dtype)


def rope(x, pos, base):
    half = x.shape[-1] // 2
    freqs = base ** (-jnp.arange(half, dtype=jnp.float32) / half)
    ang = pos[:, None] * freqs[None, :]
    cos = jnp.cos(ang)[None, :, None, :].astype(x.dtype)
    sin = jnp.sin(ang)[None, :, None, :].astype(x.dtype)
    x1, x2 = x[..., :half], x[..., half:]
    return jnp.concatenate([x1 * cos - x2 * sin, x1 * sin + x2 * cos], axis=-1)


def axial_rope(x, row_pos, col_pos, base):
    d2 = x.shape[-1] // 2
    return jnp.concatenate([rope(x[..., :d2], row_pos, base), rope(x[..., d2:], col_pos, base)], axis=-1)


def block_attention(q, k, v, scale):
    B, L, KH, G, D = q.shape
    nb = L // Q_BLOCK
    qb = q.reshape(B, nb, Q_BLOCK, KH, G, D).transpose(1, 0, 2, 3, 4, 5)

    def one(qi):
        s = jnp.einsum('bqhgd,bshd->bhgqs', qi, k, preferred_element_type=jnp.float32) * scale
        p = jax.nn.softmax(s, axis=-1).astype(v.dtype)
        return jnp.einsum('bhgqs,bshe->bqhge', p, v)

    o = lax.map(one, qb)
    return o.transpose(1, 0, 2, 3, 4, 5).reshape(B, L, KH, G, v.shape[-1])


def to_chunks(a, chunk):
    B, L, H, d = a.shape
    return a.reshape(B, L // chunk, chunk, H, d).transpose(1, 0, 2, 3, 4)


def from_chunks(a):
    N, B, C, H, d = a.shape
    return a.transpose(1, 0, 2, 3, 4).reshape(B, N * C, H, d)


def retention_scan(q, k, v, log_gamma):
    B, L, H, dk = q.shape
    dv = v.shape[-1]
    C = RET_CHUNK
    idx = jnp.arange(C, dtype=jnp.float32)
    diff = idx[:, None] - idx[None, :]
    decay_intra = jnp.where(diff[None] >= 0, jnp.exp(jnp.maximum(diff, 0.0)[None] * log_gamma[:, None, None]), 0.0)
    q_decay = jnp.exp((idx + 1.0)[:, None] * log_gamma[None, :])
    k_decay = jnp.exp((C - 1.0 - idx)[:, None] * log_gamma[None, :])
    chunk_decay = jnp.exp(C * log_gamma)

    def step(S, xs):
        qc, kc, vc = xs
        s = jnp.einsum('bihd,bjhd->bhij', qc, kc) * decay_intra[None]
        o = jnp.einsum('bhij,bjhe->bihe', s, vc) + jnp.einsum('bihd,bhde->bihe', qc * q_decay[None, :, :, None], S)
        S = S * chunk_decay[None, :, None, None] + jnp.einsum('bjhd,bjhe->bhde', kc * k_decay[None, :, :, None], vc)
        return S, o

    S0 = jnp.zeros((B, H, dk, dv), q.dtype)
    _, o = lax.scan(step, S0, (to_chunks(q, C), to_chunks(k, C), to_chunks(v, C)))
    return from_chunks(o)


def gated_scan(q, k, v, log_f):
    B, L, H, dk = q.shape
    dv = v.shape[-1]
    C = HG_CHUNK
    mask = jnp.tril(jnp.ones((C, C), dtype=bool))

    def step(S, xs):
        qc, kc, vc, lf = xs
        b = jnp.cumsum(lf, axis=1)
        q_t = qc * jnp.exp(b)
        k_t = kc * jnp.exp(-b)
        s = jnp.where(mask[None, None], jnp.einsum('bihd,bjhd->bhij', q_t, k_t), 0.0)
        o = jnp.einsum('bhij,bjhe->bihe', s, vc) + jnp.einsum('bihd,bhde->bihe', q_t, S)
        b_last = b[:, -1:]
        S = S * jnp.exp(b_last[:, 0])[..., None] + jnp.einsum('bjhd,bjhe->bhde', kc * jnp.exp(b_last - b), vc)
        return S, o

    S0 = jnp.zeros((B, H, dk, dv), q.dtype)
    _, o = lax.scan(step, S0, (to_chunks(q, C), to_chunks(k, C), to_chunks(v, C), to_chunks(log_f, C)))
    return from_chunks(o)


def retention_mixer(h, w_in, decay_logit, out_norm, w_out):
    B, L, _ = h.shape
    qk = RET_HEADS * RET_DK
    vw = RET_HEADS * RET_DV
    q, k, v, g = jnp.split(h @ w_in, [qk, 2 * qk, 2 * qk + vw], axis=-1)
    pos = jnp.arange(L, dtype=jnp.float32)
    q = rope(q.reshape(B, L, RET_HEADS, RET_DK), pos, RET_ROPE_BASE).astype(jnp.float32) * (RET_DK ** -0.5)
    k = rope(k.reshape(B, L, RET_HEADS, RET_DK), pos, RET_ROPE_BASE).astype(jnp.float32)
    v = v.reshape(B, L, RET_HEADS, RET_DV).astype(jnp.float32)
    lg = jax.nn.log_sigmoid(decay_logit.astype(jnp.float32))
    o_f = retention_scan(q, k, v, lg[0])
    o_b = jnp.flip(retention_scan(jnp.flip(q, 1), jnp.flip(k, 1), jnp.flip(v, 1), lg[1]), 1)
    o = rmsnorm(o_f + o_b, out_norm).astype(h.dtype) * jax.nn.silu(g).reshape(B, L, RET_HEADS, RET_DV)
    return o.reshape(B, L, vw) @ w_out


def hgrn2_mixer(h, w_in, lb, out_norm, w_out):
    B, L, _ = h.shape
    kw = HG_HEADS * HG_DK
    vw = HG_HEADS * HG_DV
    q, f_fw, f_bw, i, g = jnp.split(h @ w_in, [kw, 2 * kw, 3 * kw, 3 * kw + vw], axis=-1)
    lbf = lb.astype(jnp.float32)

    def gates(fz):
        f = lbf + (1.0 - lbf) * jax.nn.sigmoid(fz.astype(jnp.float32))
        return jnp.log(f).reshape(B, L, HG_HEADS, HG_DK), (1.0 - f).reshape(B, L, HG_HEADS, HG_DK)

    q = q.astype(jnp.float32).reshape(B, L, HG_HEADS, HG_DK)
    iv = i.astype(jnp.float32).reshape(B, L, HG_HEADS, HG_DV)
    lf_f, k_f = gates(f_fw)
    lf_b, k_b = gates(f_bw)
    o_f = gated_scan(q, k_f, iv, lf_f)
    o_b = jnp.flip(gated_scan(jnp.flip(q, 1), jnp.flip(k_b, 1), jnp.flip(iv, 1), jnp.flip(lf_b, 1)), 1)
    o = rmsnorm(o_f + o_b, out_norm).astype(h.dtype) * jax.nn.silu(g).reshape(B, L, HG_HEADS, HG_DV)
    return o.reshape(B, L, vw) @ w_out


def mla_mixer(h, w_in, q_norm, kv_norm, w_qb, w_kvb, qk_norm, w_out):
    B, L, _ = h.shape
    cq, ckv, k_rope = jnp.split(h @ w_in, [MLA_Q_RANK, MLA_Q_RANK + MLA_KV_RANK], axis=-1)
    q = (rmsnorm(cq, q_norm) @ w_qb).reshape(B, L, MLA_HEADS, MLA_NOPE + MLA_ROPE)
    kv = (rmsnorm(ckv, kv_norm) @ w_kvb).reshape(B, L, MLA_HEADS, MLA_NOPE + MLA_V)
    k_nope, v = kv[..., :MLA_NOPE], kv[..., MLA_NOPE:]
    k = jnp.concatenate([k_nope, jnp.broadcast_to(k_rope[:, :, None, :], (B, L, MLA_HEADS, MLA_ROPE))], axis=-1)
    q = rmsnorm(q, qk_norm[0])
    k = rmsnorm(k, qk_norm[1])
    pos = jnp.arange(L, dtype=jnp.float32)
    q = jnp.concatenate([q[..., :MLA_NOPE], rope(q[..., MLA_NOPE:], pos, MLA_ROPE_BASE)], axis=-1)
    k = jnp.concatenate([k[..., :MLA_NOPE], rope(k[..., MLA_NOPE:], pos, MLA_ROPE_BASE)], axis=-1)
    o = block_attention(q[:, :, :, None, :], k, v, (MLA_NOPE + MLA_ROPE) ** -0.5)
    return o.reshape(B, L, MLA_HEADS * MLA_V) @ w_out


def gqa_mixer(h, w_in, qk_norm, w_out):
    B, L, _ = h.shape
    qw = GQA_HEADS * GQA_HD
    kvw = GQA_KV_HEADS * GQA_HD
    q, k, v = jnp.split(h @ w_in, [qw, qw + kvw], axis=-1)
    q = rmsnorm(q.reshape(B, L, GQA_HEADS, GQA_HD), qk_norm[0])
    k = rmsnorm(k.reshape(B, L, GQA_KV_HEADS, GQA_HD), qk_norm[1])
    rows = L // GRID_W
    row_pos = jnp.repeat(jnp.arange(rows), GRID_W).astype(jnp.float32)
    col_pos = jnp.tile(jnp.arange(GRID_W), rows).astype(jnp.float32)
    q = axial_rope(q, row_pos, col_pos, GQA_ROPE_BASE)
    k = axial_rope(k, row_pos, col_pos, GQA_ROPE_BASE)
    q = q.reshape(B, L, GQA_KV_HEADS, GQA_HEADS // GQA_KV_HEADS, GQA_HD)
    o = block_attention(q, k, v.reshape(B, L, GQA_KV_HEADS, GQA_HD), GQA_HD ** -0.5)
    return o.reshape(B, L, qw) @ w_out


def memory_xattn(h, m, w_q, w_kv, qk_norm, w_out):
    B, L, _ = h.shape
    M = m.shape[1]
    q = rmsnorm((h @ w_q).reshape(B, L, MEM_HEADS, MEM_HD), qk_norm[0])
    kv = (m @ w_kv).reshape(B, M, 2, MEM_HEADS, MEM_HD)
    k = rmsnorm(kv[:, :, 0], qk_norm[1])
    v = kv[:, :, 1]
    s = jnp.einsum('blhd,bmhd->bhlm', q, k, preferred_element_type=jnp.float32) * (MEM_HD ** -0.5)
    p = jax.nn.softmax(s, axis=-1).astype(v.dtype)
    o = jnp.einsum('bhlm,bmhd->blhd', p, v)
    return o.reshape(B, L, MEM_HEADS * MEM_HD) @ w_out


def sq_relu_mlp(h, w1, w2):
    a = jax.nn.relu(h @ w1)
    return (a * a) @ w2


def trunk(x, mem, p):
    s = jax.nn.softmax(p['hg_lb'].astype(jnp.float32), axis=0)
    lb_all = jnp.cumsum(s, axis=0) - s[0]
    for i in range(DEPTH):
        kind, j = i % N_MIXERS, i // N_MIXERS
        h = rmsnorm(x, p['norm_mix'][i])
        if kind == 0:
            x = x + retention_mixer(h, p['ret_w_in'][j], p['ret_decay'][j], p['ret_out_norm'][j], p['ret_w_out'][j])
        elif kind == 1:
            x = x + hgrn2_mixer(h, p['hg_w_in'][j], lb_all[i], p['hg_out_norm'][j], p['hg_w_out'][j])
        elif kind == 2:
            x = x + mla_mixer(h, p['mla_w_in'][j], p['mla_q_norm'][j], p['mla_kv_norm'][j], p['mla_w_qb'][j],
                              p['mla_w_kvb'][j], p['mla_qk_norm'][j], p['mla_w_out'][j])
        else:
            x = x + gqa_mixer(h, p['gqa_w_in'][j], p['gqa_qk_norm'][j], p['gqa_w_out'][j])
        h = rmsnorm(x, p['norm_mem'][i])
        m = rmsnorm(mem, p['norm_memtok'][i])
        x = x + memory_xattn(h, m, p['mem_w_q'][i], p['mem_w_kv'][i], p['mem_qk_norm'][i], p['mem_w_out'][i])
        h = rmsnorm(x, p['norm_mlp'][i])
        x = x + sq_relu_mlp(h, p['mlp_w1'][i], p['mlp_w2'][i])
    return x


def setup_inputs(seed: int = 0) -> dict:
    key = jax.random.key(seed)
    ks = iter(jax.random.split(key, 40))

    def nrm(shape, scale):
        return scale * jax.random.normal(next(ks), shape, jnp.float32)

    def dense(shape):
        return nrm(shape, shape[-2] ** -0.5)

    def gain(shape):
        return 1.0 + nrm(shape, 0.02)

    hidx = jnp.arange(RET_HEADS, dtype=jnp.float32)
    ret_logit0 = jnp.log(2.0 ** (5.0 + hidx) - 1.0)
    ret_in_w = 2 * RET_HEADS * RET_DK + 2 * RET_HEADS * RET_DV
    hg_in_w = 3 * HG_HEADS * HG_DK + 2 * HG_HEADS * HG_DV
    return {
        'x_prompt': nrm((BATCH, SEQ, D_MODEL), 1.0),
        'x_sample': nrm((DEC_BATCH, DEC_SEQ, D_MODEL), 1.0),
        'mem_prompt': nrm((BATCH, MEM_TOKENS, D_MODEL), 1.0),
        'mem_sample': nrm((DEC_BATCH, MEM_TOKENS, D_MODEL), 1.0),
        'norm_mix': gain((DEPTH, D_MODEL)),
        'norm_mem': gain((DEPTH, D_MODEL)),
        'norm_memtok': gain((DEPTH, D_MODEL)),
        'norm_mlp': gain((DEPTH, D_MODEL)),
        'ret_w_in': dense((N_RET, D_MODEL, ret_in_w)),
        'ret_decay': ret_logit0[None, None, :] + nrm((N_RET, 2, RET_HEADS), 0.05),
        'ret_out_norm': gain((N_RET, RET_DV)),
        'ret_w_out': dense((N_RET, RET_HEADS * RET_DV, D_MODEL)),
        'hg_w_in': dense((N_HG, D_MODEL, hg_in_w)),
        'hg_lb': nrm((DEPTH, HG_HEADS * HG_DK), 0.1),
        'hg_out_norm': gain((N_HG, HG_DV)),
        'hg_w_out': dense((N_HG, HG_HEADS * HG_DV, D_MODEL)),
        'mla_w_in': dense((N_MLA, D_MODEL, MLA_Q_RANK + MLA_KV_RANK + MLA_ROPE)),
        'mla_q_norm': gain((N_MLA, MLA_Q_RANK)),
        'mla_kv_norm': gain((N_MLA, MLA_KV_RANK)),
        'mla_w_qb': dense((N_MLA, MLA_Q_RANK, MLA_HEADS * (MLA_NOPE + MLA_ROPE))),
        'mla_w_kvb': dense((N_MLA, MLA_KV_RANK, MLA_HEADS * (MLA_NOPE + MLA_V))),
        'mla_qk_norm': gain((N_MLA, 2, MLA_NOPE + MLA_ROPE)),
        'mla_w_out': dense((N_MLA, MLA_HEADS * MLA_V, D_MODEL)),
        'gqa_w_in': dense((N_GQA, D_MODEL, (GQA_HEADS + 2 * GQA_KV_HEADS) * GQA_HD)),
        'gqa_qk_norm': gain((N_GQA, 2, GQA_HD)),
        'gqa_w_out': dense((N_GQA, GQA_HEADS * GQA_HD, D_MODEL)),
        'mem_w_q': dense((DEPTH, D_MODEL, MEM_HEADS * MEM_HD)),
        'mem_w_kv': dense((DEPTH, D_MODEL, 2 * MEM_HEADS * MEM_HD)),
        'mem_qk_norm': gain((DEPTH, 2, MEM_HD)),
        'mem_w_out': dense((DEPTH, MEM_HEADS * MEM_HD, D_MODEL)),
        'mlp_w1': dense((DEPTH, D_MODEL, D_FF)),
        'mlp_w2': dense((DEPTH, D_FF, D_MODEL)),
    }


def reference(x_prompt, x_sample, mem_prompt, mem_sample, norm_mix, norm_mem, norm_memtok, norm_mlp,
              ret_w_in, ret_decay, ret_out_norm, ret_w_out, hg_w_in, hg_lb, hg_out_norm, hg_w_out,
              mla_w_in, mla_q_norm, mla_kv_norm, mla_w_qb, mla_w_kvb, mla_qk_norm, mla_w_out,
              gqa_w_in, gqa_qk_norm, gqa_w_out, mem_w_q, mem_w_kv, mem_qk_norm, mem_w_out, mlp_w1, mlp_w2):
    params = dict(norm_mix=norm_mix, norm_mem=norm_mem, norm_memtok=norm_memtok, norm_mlp=norm_mlp,
                  ret_w_in=ret_w_in, ret_decay=ret_decay, ret_out_norm=ret_out_norm, ret_w_out=ret_w_out,
                  hg_w_in=hg_w_in, hg_lb=hg_lb, hg_out_norm=hg_out_norm, hg_w_out=hg_w_out,
                  mla_w_in=mla_w_in, mla_q_norm=mla_q_norm, mla_kv_norm=mla_kv_norm, mla_w_qb=mla_w_qb,
                  mla_w_kvb=mla_w_kvb, mla_qk_norm=mla_qk_norm, mla_w_out=mla_w_out,
                  gqa_w_in=gqa_w_in, gqa_qk_norm=gqa_qk_norm, gqa_w_out=gqa_w_out,
                  mem_w_q=mem_w_q, mem_w_kv=mem_w_kv, mem_qk_norm=mem_qk_norm, mem_w_out=mem_w_out,
                  mlp_w1=mlp_w1, mlp_w2=mlp_w2)
    y_prompt = trunk(x_prompt, mem_prompt, params)
    y_sample = trunk(x_sample, mem_sample, params)
    return (y_prompt, y_sample)
```

```cpp
#include <hip/hip_runtime.h>
#include <cstdio>
#include <cstdint>

#define LAS __attribute__((address_space(3)))
#ifndef REP_RET
#define REP_RET 1
#endif
#ifndef REP_HG
#define REP_HG 1
#endif
#ifndef REP_ATTN
#define REP_ATTN 1
#endif
#ifndef REP_GEMMBF
#define REP_GEMMBF 1
#endif
#ifndef REP_NORM
#define REP_NORM 1
#endif
#ifndef WGM_RES
#define WGM_RES 4
#endif
#ifndef WGM_MLP1
#define WGM_MLP1 4
#endif
#ifndef WGM_IN
#define WGM_IN 4
#endif
#ifndef REP_BAR
#define REP_BAR 1
#endif
#ifndef REP_CONV
#define REP_CONV 1
#endif
typedef unsigned short bf16_t;
typedef short bf16x8 __attribute__((ext_vector_type(8)));
typedef short s16x4 __attribute__((ext_vector_type(4)));
typedef float f32x4 __attribute__((ext_vector_type(4)));
typedef float f32x16 __attribute__((ext_vector_type(16)));
typedef unsigned u32x2 __attribute__((ext_vector_type(2)));
typedef unsigned u32x4 __attribute__((ext_vector_type(4)));

constexpr int DM = 2048, SEQ = 2048, NBATCH = 24, GSEQ = 8, T = GSEQ * SEQ, NGROUP = 3, MEMT = 256, MROWS = NBATCH * MEMT;
constexpr float EPS = 1e-6f;
constexpr int NWAVES = 8, NTHREADS = 512;
#ifndef MLP_NG
#define MLP_NG 6
#endif
constexpr int MLP_T = NBATCH * SEQ / MLP_NG;

constexpr size_t MiB = 1u << 20;
constexpr size_t WS_CTL = 0, CTL_BYTES = 1 * MiB;
constexpr size_t WS_TAB = 1 * MiB;
constexpr size_t TAB_RC = 0, TAB_RS = 1 * MiB, TAB_MC = 2 * MiB, TAB_MS = 2 * MiB + 256 * 1024;
constexpr size_t WS_MN = 4 * MiB;
constexpr size_t WS_MEMKV = 28 * MiB;
constexpr size_t WS_WL = 40 * MiB;
constexpr size_t WS_H = 184 * MiB;
constexpr size_t WS_QM = 248 * MiB;
constexpr size_t WS_OM = 264 * MiB;
constexpr size_t WS_OB = 280 * MiB;
constexpr size_t WS_BIG = 408 * MiB;
constexpr size_t WS_XB = 808 * MiB;
constexpr size_t WS_SSQ = 1000 * MiB;
constexpr size_t WS_END = 1002 * MiB;
constexpr size_t W_MEMQ = 0, W_MEMKV = W_MEMQ + 512 * 2048, W_MEMOUT = W_MEMKV + 1024 * 2048, W_1 = W_MEMOUT + 2048 * 512, W_2 = W_1 + (size_t)8192 * 2048,
                 W_IN = W_2 + (size_t)2048 * 8192, W_OUT = W_IN + (size_t)12288 * 2048, W_QB = W_OUT + (size_t)2048 * 4096, W_KVB = W_QB + 3072 * 512, W_TOTAL = W_KVB + 4096 * 512;
static_assert(W_TOTAL * 2 <= 144 * MiB, "weights region");
constexpr size_t MLA_C = 0, MLA_CQ = 120 * MiB, MLA_Q = 122 * MiB, MLA_KV = 218 * MiB;

constexpr int LDS_BYTES = 147456;
constexpr int MISC_OFF = 131072;
constexpr int EPI_TAB_OFF = 132096;

typedef float f32x2_ __attribute__((ext_vector_type(2)));
typedef __bf16 bf16x2_ __attribute__((ext_vector_type(2)));
__device__ __forceinline__ unsigned cvt_pk_bf16(float lo, float hi) { const f32x2_ v = {lo, hi}; const bf16x2_ b = __builtin_convertvector(v, bf16x2_); return __builtin_bit_cast(unsigned, b); }
__device__ __forceinline__ float bf_lo(unsigned w) { return __uint_as_float(w << 16); }
__device__ __forceinline__ float bf_hi(unsigned w) { return __uint_as_float(w & 0xffff0000u); }
__device__ __forceinline__ void ld8(const bf16_t* p, float (&v)[8]) { const u32x4 w = *(const u32x4*)p; v[0] = bf_lo(w.x); v[1] = bf_hi(w.x); v[2] = bf_lo(w.y); v[3] = bf_hi(w.y); v[4] = bf_lo(w.z); v[5] = bf_hi(w.z); v[6] = bf_lo(w.w); v[7] = bf_hi(w.w); }
__device__ __forceinline__ void st8(bf16_t* p, const float (&v)[8]) { u32x4 w; w.x = cvt_pk_bf16(v[0], v[1]); w.y = cvt_pk_bf16(v[2], v[3]); w.z = cvt_pk_bf16(v[4], v[5]); w.w = cvt_pk_bf16(v[6], v[7]); *(u32x4*)p = w; }
__device__ __forceinline__ float wave_sum(float v) {
#pragma unroll
    for (int o = 1; o < 64; o <<= 1) v += __shfl_xor(v, o);
    return v;
}
__device__ __forceinline__ float sigmoidf_(float x) { return __builtin_amdgcn_rcpf(1.0f + __expf(-x)); }
#define LDS_WAIT() asm volatile("s_waitcnt lgkmcnt(0)" ::: "memory")

#define XB_TMO      128
#define XB_XCNT(j)  (256  + 64 * (j))
#define XB_XSUB(j)  (1280 + 64 * (j))
#define XB_XGEN(j)  (2304 + 64 * (j))
#define XB_TOP      3328
#define XB_TOPGEN   3392
#define XCD_BAR_WORDS 3456
#define XB_SPIN_CAP (1u << 24)

typedef __attribute__((address_space(1))) unsigned gu32_t;
__device__ __forceinline__ unsigned xb_ld(unsigned* p)              { return __hip_atomic_load((gu32_t*)p, __ATOMIC_RELAXED, __HIP_MEMORY_SCOPE_AGENT); }
__device__ __forceinline__ unsigned xb_add(unsigned* p, unsigned v) { return __hip_atomic_fetch_add((gu32_t*)p, v, __ATOMIC_RELAXED, __HIP_MEMORY_SCOPE_AGENT); }
__device__ __forceinline__ unsigned xb_xcc_id() { return (unsigned)__builtin_amdgcn_s_getreg((3 << 11) | 20) & 0xFu; }
#define XB_SPIN(cond, bar) do { unsigned _sp = 0; while (cond) { __builtin_amdgcn_s_sleep(1); \
    if ((++_sp & 255u) == 0u) { if (xb_ld(&(bar)[XB_TMO])) break; if (_sp > XB_SPIN_CAP) { (void)xb_add(&(bar)[XB_TMO], 1u); break; } } } } while (0)

struct XcdBarrier { unsigned* bar; unsigned x; volatile LAS unsigned* st; };

__device__ __forceinline__ XcdBarrier xcd_barrier_post(unsigned* bar, volatile LAS unsigned* st) {
    XcdBarrier b; b.bar = bar; b.x = xb_xcc_id(); b.st = st;
    if (threadIdx.x == 0) (void)xb_add(&bar[XB_XCNT(b.x)], 1u);
    return b;
}
__device__ __forceinline__ void xcd_barrier_complete(unsigned* bar, unsigned x, unsigned& nloc, unsigned& nx) {
    const unsigned G = gridDim.x * gridDim.y * gridDim.z;
    unsigned sum, cnt, mine, sp = 0u;
    for (;;) {
        sum = 0u; cnt = 0u; mine = 0u;
#pragma unroll
        for (unsigned j = 0; j < 16; ++j) { const unsigned c = xb_ld(&bar[XB_XCNT(j)]); sum += c; cnt += (c > 0u) ? 1u : 0u; mine = (j == x) ? c : mine; }
        if (sum == G) break;
        __builtin_amdgcn_s_sleep(1);
        if ((++sp & 255u) == 0u) { if (xb_ld(&bar[XB_TMO])) break; if (sp > XB_SPIN_CAP) { (void)xb_add(&bar[XB_TMO], 1u); break; } }
    }
    nloc = mine > 0u ? mine : 1u; nx = cnt > 0u ? cnt : 1u;
}
__device__ __forceinline__ void xcd_barrier(const XcdBarrier& b) {
    asm volatile("s_waitcnt vmcnt(0)" ::: "memory");
    __syncthreads();
    if (threadIdx.x == 0) {
        unsigned* bar = b.bar; asm volatile("" : "+s"(bar)); unsigned bx = b.x; asm volatile("" : "+s"(bx));
        __builtin_amdgcn_s_waitcnt(0);
        unsigned nloc = b.st[0], nx = b.st[1];
        if (nloc == 0u) { xcd_barrier_complete(bar, bx, nloc, nx); b.st[0] = nloc; b.st[1] = nx; }
        const unsigned old = xb_add(&bar[XB_XSUB(bx)], 1u);
        const unsigned gen = old / nloc;
        if (old + 1u == (gen + 1u) * nloc) {
            __builtin_amdgcn_fence(__ATOMIC_RELEASE, "agent");
            asm volatile("s_waitcnt vmcnt(0)" ::: "memory");
            const unsigned og = xb_add(&bar[XB_TOP], 1u);
            const unsigned tg = og / nx;
            if (og + 1u == (tg + 1u) * nx) xb_add(&bar[XB_TOPGEN], 1u);
            else XB_SPIN(xb_ld(&bar[XB_TOPGEN]) == tg, bar);
            __builtin_amdgcn_fence(__ATOMIC_ACQUIRE, "agent");
            xb_add(&bar[XB_XGEN(bx)], 1u);
            asm volatile("s_waitcnt vmcnt(0)" ::: "memory");
        } else {
            XB_SPIN(xb_ld(&bar[XB_XGEN(bx)]) == gen, bar);
            __builtin_amdgcn_fence(__ATOMIC_ACQUIRE, "agent");
            asm volatile("s_waitcnt vmcnt(0)" ::: "memory");
        }
    }
    __syncthreads();
}

namespace pg8 {
constexpr int BM = 256, BK = 64, HALF = 128, HTB = HALF * BK * 2, STAGE_BYTES = 8 * HTB, NXCD = 8, WGM = 8;
__host__ __device__ __forceinline__ int lds_byte(int r, int c) { const int st = (r >> 4) * 2 + (c >> 5), rr = r & 15, cc = c & 31, ob = rr * 64 + cc * 2; return st * 1024 + (ob ^ (((ob >> 9) & 1) << 5)); }
__host__ __device__ __forceinline__ void stage_rc(int b, int& R, int& C) { const int st = b / 1024, sb = b % 1024, swz = sb ^ (((sb >> 9) & 1) << 5); R = (st >> 1) * 16 + swz / 64; C = (st & 1) * 32 + (swz % 64) / 2; }
__host__ __device__ __forceinline__ int perm32(int rho) { const int n = rho >> 4, i = rho & 15; return 8 * (i >> 2) + 4 * n + (i & 3); }

struct Unit { int pm, pn; };
struct Gemm { const bf16_t* A; const bf16_t* Bt; int M, N, K; int lda = 0; };

struct StaticOrder {
    int nM, nN, nwg, G, c, wgm;
    __host__ __device__ void init(int M, int N, int G_, int c_, int wgm_ = 4) { nM = M / BM; nN = N / BM; nwg = nM * nN; G = G_; c = c_; wgm = wgm_; }
    __host__ __device__ bool next(int i, Unit& u) const {
        const long L = (long)i * G + c; if (L >= nwg) return false;
        int wgid = (int)L; { const int q = nwg / NXCD, r = nwg % NXCD, xcd = wgid % NXCD, off = wgid / NXCD; wgid = (xcd < r ? xcd * (q + 1) : r * (q + 1) + (xcd - r) * q) + off; }
        const int nig = wgm * nN, gid = wgid / nig, fm = gid * wgm, gsz = (nM - fm) < wgm ? (nM - fm) : wgm;
        u.pm = fm + ((wgid % nig) % gsz); u.pn = (wgid % nig) / gsz; return true;
    }
    __device__ __forceinline__ void a_ready(const Unit&) const {}
    __device__ __forceinline__ void done(const Unit&) const {}
};

template <int ACT  , bool RS = false  ,
          int SO = -1  , bool SSOUT = false  > struct EpiBf16 {
    static constexpr bool PERM = true;
    bf16_t* O; int ldc; const float* SSQ; float* SS2 = nullptr; LAS float* tab = nullptr;
    __device__ __forceinline__ void operator()(const f32x4 (&acc)[2][2][4][2], const Unit& u, int wr, int wc, int fr, int fq) const {
        const int row0 = u.pm * BM + wr * 64 + fr, col0 = u.pn * BM + wc * 32 + 8 * fq;
        float rsv[2][4];
#pragma unroll
        for (int ai = 0; ai < 2; ++ai)
#pragma unroll
            for (int m = 0; m < 4; ++m) { float rs = 1.f;
                if (RS && SO < 0) { const f32x4 p0 = *(const f32x4*)(SSQ + (size_t)(row0 + ai * HALF + m * 16) * 8), p1 = *(const f32x4*)(SSQ + (size_t)(row0 + ai * HALF + m * 16) * 8 + 4);
                    rs = rsqrtf(((p0[0] + p0[1]) + (p0[2] + p0[3]) + (p1[0] + p1[1]) + (p1[2] + p1[3])) * (1.f / DM) + EPS); }
                if (SO >= 0) { const f32x4 p0 = *(const f32x4*)(SSQ + (size_t)(row0 + ai * HALF + m * 16) * 8); rs = rsqrtf((p0[SO & 3] + p0[(SO + 1) & 3]) * (1.f / 512.f) + EPS); }
                rsv[ai][m] = rs; }
        if (RS || SO >= 0) asm volatile("" : "+v"(rsv[0][0]), "+v"(rsv[0][1]), "+v"(rsv[0][2]), "+v"(rsv[0][3]), "+v"(rsv[1][0]), "+v"(rsv[1][1]), "+v"(rsv[1][2]), "+v"(rsv[1][3]));
#pragma unroll
        for (int ai = 0; ai < 2; ++ai)
#pragma unroll
            for (int m = 0; m < 4; ++m) { bf16_t* rowp = O + (size_t)(row0 + ai * HALF + m * 16) * ldc + col0;
                const float rs = rsv[ai][m]; float ps = 0.f;
#pragma unroll
                for (int bj = 0; bj < 2; ++bj) { f32x4 v0 = acc[ai][bj][m][0] * rs, v1 = acc[ai][bj][m][1] * rs;
                    if (ACT == 1) {
#pragma unroll
                        for (int j = 0; j < 4; ++j) { const float a = fmaxf(v0[j], 0.f), b = fmaxf(v1[j], 0.f); v0[j] = a * a; v1[j] = b * b; } }
                    if (SSOUT) ps += (v0[0] * v0[0] + v0[1] * v0[1]) + (v0[2] * v0[2] + v0[3] * v0[3]) + (v1[0] * v1[0] + v1[1] * v1[1]) + (v1[2] * v1[2] + v1[3] * v1[3]);
                    u32x4 w; w.x = cvt_pk_bf16(v0[0], v0[1]); w.y = cvt_pk_bf16(v0[2], v0[3]); w.z = cvt_pk_bf16(v1[0], v1[1]); w.w = cvt_pk_bf16(v1[2], v1[3]);
                    *(u32x4*)(rowp + bj * HALF) = w; }
                if (SSOUT) { ps += __shfl_xor(ps, 16); ps += __shfl_xor(ps, 32); if (fq == 0) tab[(ai * HALF + wr * 64 + m * 16 + fr) * 4 + wc] = ps; } }
        if (SSOUT) {
            asm volatile("s_waitcnt lgkmcnt(0)" ::: "memory"); __builtin_amdgcn_s_barrier(); asm volatile("" ::: "memory");
            const int t = threadIdx.x;
            if (t < 256) { const f32x4 p = *(LAS const f32x4*)(tab + t * 4); SS2[(size_t)(u.pm * BM + t) * 8 + u.pn] = (p[0] + p[1]) + (p[2] + p[3]); }
        }
    }
};
template <bool FINAL> struct EpiResidX {
    static constexpr bool PERM = true;
    bf16_t* XB; float* SSQ; LAS float* tab; float* OUT;
    __device__ __forceinline__ void operator()(const f32x4 (&acc)[2][2][4][2], const Unit& u, int wr, int wc, int fr, int fq) const {
        const int row0 = u.pm * BM + wr * 64 + fr, col0 = u.pn * BM + wc * 32 + 8 * fq;
        u32x4 xw[2][4][2];
#pragma unroll
        for (int ai = 0; ai < 2; ++ai)
#pragma unroll
            for (int m = 0; m < 4; ++m)
#pragma unroll
                for (int bj = 0; bj < 2; ++bj) xw[ai][m][bj] = *(const u32x4*)(XB + (size_t)(row0 + ai * HALF + m * 16) * DM + col0 + bj * HALF);
#pragma unroll
        for (int ai = 0; ai < 2; ++ai)
#pragma unroll
            for (int m = 0; m < 4; ++m) { const size_t ro = (size_t)(row0 + ai * HALF + m * 16) * DM + col0; float ps = 0.f;
#pragma unroll
                for (int bj = 0; bj < 2; ++bj) { const u32x4 w4 = xw[ai][m][bj];
                    const f32x4 x0 = (f32x4){bf_lo(w4.x), bf_hi(w4.x), bf_lo(w4.y), bf_hi(w4.y)} + acc[ai][bj][m][0], x1 = (f32x4){bf_lo(w4.z), bf_hi(w4.z), bf_lo(w4.w), bf_hi(w4.w)} + acc[ai][bj][m][1];
                    if (FINAL) { __builtin_nontemporal_store(x0, (f32x4*)(OUT + ro + bj * HALF)); __builtin_nontemporal_store(x1, (f32x4*)(OUT + ro + bj * HALF + 4)); }
                    else {
                        ps += (x0[0] * x0[0] + x0[1] * x0[1]) + (x0[2] * x0[2] + x0[3] * x0[3]) + (x1[0] * x1[0] + x1[1] * x1[1]) + (x1[2] * x1[2] + x1[3] * x1[3]);
                        u32x4 w; w.x = cvt_pk_bf16(x0[0], x0[1]); w.y = cvt_pk_bf16(x0[2], x0[3]); w.z = cvt_pk_bf16(x1[0], x1[1]); w.w = cvt_pk_bf16(x1[2], x1[3]);
                        *(u32x4*)(XB + ro + bj * HALF) = w; } }
                if (!FINAL) { ps += __shfl_xor(ps, 16); ps += __shfl_xor(ps, 32);
                    if (fq == 0) tab[(ai * HALF + wr * 64 + m * 16 + fr) * 4 + wc] = ps; } }
        if (!FINAL) {
            asm volatile("s_waitcnt lgkmcnt(0)" ::: "memory"); __builtin_amdgcn_s_barrier(); asm volatile("" ::: "memory");
            const int t = threadIdx.x;
            if (t < 256) { const f32x4 p = *(LAS const f32x4*)(tab + t * 4); SSQ[(size_t)(u.pm * BM + t) * 8 + u.pn] = (p[0] + p[1]) + (p[2] + p[3]); }
        }
    }
};
struct EpiRetIn {
    static constexpr bool PERM = true;
    bf16_t* O; int ldc; const float* SSQ; const float* ct; const float* st;
    __device__ __forceinline__ void operator()(const f32x4 (&acc)[2][2][4][2], const Unit& u, int wr, int wc, int fr, int fq) const {
        const int row0 = u.pm * BM + wr * 64 + fr, col0 = u.pn * BM + wc * 32 + 8 * fq; const bool rope = u.pn < 16; const float qs = u.pn < 8 ? 0.0625f : 1.f;
#pragma unroll
        for (int ai = 0; ai < 2; ++ai)
#pragma unroll
            for (int m = 0; m < 4; ++m) { const int row = row0 + ai * HALF + m * 16; bf16_t* rowp = O + (size_t)row * ldc + col0;
                const f32x4 p0 = *(const f32x4*)(SSQ + (size_t)row * 8), p1 = *(const f32x4*)(SSQ + (size_t)row * 8 + 4);
                const float rs = rsqrtf(((p0[0] + p0[1]) + (p0[2] + p0[3]) + (p1[0] + p1[1]) + (p1[2] + p1[3])) * (1.f / DM) + EPS) * qs;
                f32x4 a0 = acc[ai][0][m][0] * rs, a1 = acc[ai][0][m][1] * rs, b0 = acc[ai][1][m][0] * rs, b1 = acc[ai][1][m][1] * rs;
                if (rope) { const int pos = row & (SEQ - 1); const float* cp = ct + pos * 128 + wc * 32 + 8 * fq; const float* sp = st + pos * 128 + wc * 32 + 8 * fq;
                    const f32x4 c0 = *(const f32x4*)cp, c1 = *(const f32x4*)(cp + 4), s0 = *(const f32x4*)sp, s1 = *(const f32x4*)(sp + 4);
                    const f32x4 na0 = a0 * c0 - b0 * s0, na1 = a1 * c1 - b1 * s1, nb0 = a0 * s0 + b0 * c0, nb1 = a1 * s1 + b1 * c1; a0 = na0; a1 = na1; b0 = nb0; b1 = nb1; }
                u32x4 w; w.x = cvt_pk_bf16(a0[0], a0[1]); w.y = cvt_pk_bf16(a0[2], a0[3]); w.z = cvt_pk_bf16(a1[0], a1[1]); w.w = cvt_pk_bf16(a1[2], a1[3]); *(u32x4*)rowp = w;
                w.x = cvt_pk_bf16(b0[0], b0[1]); w.y = cvt_pk_bf16(b0[2], b0[3]); w.z = cvt_pk_bf16(b1[0], b1[1]); w.w = cvt_pk_bf16(b1[2], b1[3]); *(u32x4*)(rowp + HALF) = w; }
    }
};
struct EpiResid {
    static constexpr bool PERM = false;
    const float* Xi; float* Xo; int ldc;
    __device__ __forceinline__ void operator()(const f32x4 (&acc)[2][2][4][2], const Unit& u, int wr, int wc, int fr, int fq) const {
        const int row0 = u.pm * BM + wr * 64 + fr, col0 = u.pn * BM + wc * 32 + 4 * fq;
#pragma unroll
        for (int ai = 0; ai < 2; ++ai)
#pragma unroll
            for (int m = 0; m < 4; ++m) { const size_t ro = (size_t)(row0 + ai * HALF + m * 16) * ldc + col0;
#pragma unroll
                for (int bj = 0; bj < 2; ++bj)
#pragma unroll
                    for (int n = 0; n < 2; ++n) { const f32x4 x = *(const f32x4*)(Xi + ro + bj * HALF + n * 16); *(f32x4*)(Xo + ro + bj * HALF + n * 16) = x + acc[ai][bj][m][n]; } }
    }
};

template <class Epi, class Sched>
__device__ __forceinline__ void gemm_phase(LAS unsigned char* lds, const Gemm g, const Sched& S, const Epi& E) {
    int tid = threadIdx.x; asm volatile("" : "+v"(tid));
    const int wid = __builtin_amdgcn_readfirstlane(tid >> 6), lane = tid & 63, wr = wid >> 2, wc = wid & 3, fr = lane & 15, fq = lane >> 4;
    const int K = g.K, nt = K / BK, lda = g.lda ? g.lda : K;
    unsigned voffA[2], voffB[2];
#pragma unroll
    for (int i = 0; i < 2; ++i) { int R, C; stage_rc(tid * 16 + i * 8192, R, C); const int Rb = Epi::PERM ? ((R & ~31) + perm32(R & 31)) : R;
        voffA[i] = (unsigned)(R * lda + C) * 2u; voffB[i] = (unsigned)(Rb * K + C) * 2u; }
    const size_t kstep = (size_t)(BK * 2);
    const size_t hstep = (size_t)HALF * K * 2, hstepA = (size_t)HALF * lda * 2;
    const size_t tstep = 2 * hstep, tstepA = 2 * hstepA;
    const unsigned ldsw = (unsigned)wid * 1024u;
    const int aoff = lds_byte(wr * 64 + fr, fq * 8), boff = lds_byte(wc * 32 + fr, fq * 8);
#define PG8_SA(b, h) (((b) * 2 + (h)) * HTB)
#define PG8_SB(b, h) ((4 + (b) * 2 + (h)) * HTB)
#define PG8_STAGE(bufoff, gbase, voff) do { _Pragma("unroll") for (int _i = 0; _i < 2; ++_i) \
        __builtin_amdgcn_global_load_lds((const unsigned*)((const char*)(gbase) + (voff)[_i]), (LAS unsigned*)(lds + (bufoff) + ldsw + _i * 8192), 16, 0, 0); } while (0)
#define PG8_LDA(dst, b, h) do { _Pragma("unroll") for (int m = 0; m < 4; ++m) _Pragma("unroll") for (int k = 0; k < 2; ++k) dst[m][k] = *(const LAS bf16x8*)(lds + PG8_SA(b, h) + aoff + m * 2048 + k * 1024); } while (0)
#define PG8_LDB(dst, b, h) do { _Pragma("unroll") for (int n = 0; n < 2; ++n) _Pragma("unroll") for (int k = 0; k < 2; ++k) dst[n][k] = *(const LAS bf16x8*)(lds + PG8_SB(b, h) + boff + n * 2048 + k * 1024); } while (0)
#define PG8_MMA(ai, bj, At, Bt) do { __builtin_amdgcn_s_setprio(1); _Pragma("unroll") for (int m = 0; m < 4; ++m) _Pragma("unroll") for (int n = 0; n < 2; ++n) _Pragma("unroll") for (int k = 0; k < 2; ++k) \
        acc[ai][bj][m][n] = __builtin_amdgcn_mfma_f32_16x16x32_bf16(Bt[n][k], At[m][k], acc[ai][bj][m][n], 0, 0, 0); __builtin_amdgcn_s_setprio(0); } while (0)
#define PG8_WAIT_V(n) asm volatile("s_waitcnt vmcnt(" #n ")" ::: "memory")
#define PG8_WAIT_L(n) asm volatile("s_waitcnt lgkmcnt(" #n ")" ::: "memory")
#define PG8_BAR __builtin_amdgcn_s_barrier()
#define PG8_SCHED __builtin_amdgcn_sched_barrier(0)
    Unit cur, nxt; int ui = 0;
    if (!S.next(0, cur)) return;
    f32x4 acc[2][2][4][2];
#pragma unroll
    for (int a = 0; a < 2; ++a)
#pragma unroll
        for (int b = 0; b < 2; ++b)
#pragma unroll
            for (int m = 0; m < 4; ++m)
#pragma unroll
                for (int n = 0; n < 2; ++n) acc[a][b][m][n] = (f32x4){0.f, 0.f, 0.f, 0.f};
    bf16x8 At[4][2], B0[2][2], B1[2][2];
    const char* cA = (const char*)g.A + (size_t)cur.pm * tstepA; const char* cB = (const char*)g.Bt + (size_t)cur.pn * tstep;
    S.a_ready(cur);
    PG8_STAGE(PG8_SB(0, 0), cB, voffB); PG8_STAGE(PG8_SB(0, 1), cB + hstep, voffB); PG8_STAGE(PG8_SA(0, 0), cA, voffA); PG8_STAGE(PG8_SA(0, 1), cA + hstepA, voffA);
    if (wr == 1) PG8_BAR;
    PG8_WAIT_V(2); PG8_BAR;
    PG8_STAGE(PG8_SB(1, 0), cB + kstep, voffB); PG8_STAGE(PG8_SA(1, 0), cA + kstep, voffA); PG8_STAGE(PG8_SB(1, 1), cB + hstep + kstep, voffB);
    PG8_WAIT_V(6); PG8_BAR;
    for (;;) {
        const bool has_next = S.next(ui + 1, nxt);
        const char* nA = has_next ? (const char*)g.A + (size_t)nxt.pm * tstepA : cA; const char* nB = has_next ? (const char*)g.Bt + (size_t)nxt.pn * tstep : cB;
        for (int t = 0; t < nt; t += 2) {
            const bool last = (t == nt - 2);
            const char* a1 = cA + (size_t)(t + 1) * kstep;
            const char* a2 = last ? nA : cA + (size_t)(t + 2) * kstep; const char* b2 = last ? nB : cB + (size_t)(t + 2) * kstep;
            const char* a3 = a2 + kstep; const char* b3 = b2 + kstep;
            if (last && has_next) S.a_ready(nxt);
            PG8_LDB(B0, 0, 0); PG8_LDB(B1, 0, 1); PG8_SCHED; PG8_LDA(At, 0, 0); PG8_STAGE(PG8_SA(1, 1), a1 + hstepA, voffA);
            PG8_WAIT_V(8); PG8_WAIT_L(0); PG8_BAR; PG8_MMA(0, 0, At, B0); PG8_MMA(0, 1, At, B1); PG8_BAR; PG8_SCHED;
            PG8_LDA(At, 0, 1); PG8_STAGE(PG8_SB(0, 0), b2, voffB); PG8_STAGE(PG8_SB(0, 1), b2 + hstep, voffB); PG8_STAGE(PG8_SA(0, 0), a2, voffA);
            PG8_WAIT_V(8); PG8_WAIT_L(0); PG8_BAR; PG8_MMA(1, 0, At, B0); PG8_MMA(1, 1, At, B1); PG8_BAR; PG8_SCHED;
            PG8_LDB(B0, 1, 0); PG8_LDB(B1, 1, 1); PG8_SCHED; PG8_LDA(At, 1, 0); PG8_STAGE(PG8_SA(0, 1), a2 + hstepA, voffA);
            PG8_WAIT_V(8); PG8_WAIT_L(0); PG8_BAR; PG8_MMA(0, 0, At, B0); PG8_MMA(0, 1, At, B1); PG8_BAR; PG8_SCHED;
            PG8_LDA(At, 1, 1); PG8_STAGE(PG8_SB(1, 0), b3, voffB); PG8_STAGE(PG8_SB(1, 1), b3 + hstep, voffB); PG8_STAGE(PG8_SA(1, 0), a3, voffA);
            PG8_WAIT_V(8); PG8_WAIT_L(0); PG8_BAR; PG8_MMA(1, 0, At, B0); PG8_MMA(1, 1, At, B1); PG8_BAR; PG8_SCHED;
        }
        if (wr == 0) PG8_BAR;
        E(acc, cur, wr, wc, fr, fq); S.done(cur);
        if (!has_next) break;
#pragma unroll
        for (int a = 0; a < 2; ++a)
#pragma unroll
            for (int b = 0; b < 2; ++b)
#pragma unroll
                for (int m = 0; m < 4; ++m)
#pragma unroll
                    for (int n = 0; n < 2; ++n) acc[a][b][m][n] = (f32x4){0.f, 0.f, 0.f, 0.f};
        cur = nxt; cA = nA; cB = nB; ++ui;
        if (wr == 1) PG8_BAR;
    }
    PG8_WAIT_V(0);
    PG8_BAR;
#undef PG8_SA
#undef PG8_SB
#undef PG8_STAGE
#undef PG8_LDA
#undef PG8_LDB
#undef PG8_MMA
#undef PG8_WAIT_V
#undef PG8_WAIT_L
#undef PG8_BAR
#undef PG8_SCHED
}
}

struct Params { const float* in[32]; float* out; unsigned char* ws; };
enum { I_XP = 0, I_XS, I_MP, I_MS, I_NMIX, I_NMEM, I_NMEMTOK, I_NMLP, I_RET_WIN, I_RET_DECAY, I_RET_ONORM, I_RET_WOUT, I_HG_WIN, I_HG_LB, I_HG_ONORM, I_HG_WOUT,
       I_MLA_WIN, I_MLA_QNORM, I_MLA_KVNORM, I_MLA_WQB, I_MLA_WKVB, I_MLA_QKNORM, I_MLA_WOUT, I_GQA_WIN, I_GQA_QKNORM, I_GQA_WOUT, I_MEM_WQ, I_MEM_WKV, I_MEM_QKNORM, I_MEM_WOUT, I_MLP_W1, I_MLP_W2 };

typedef const Params __attribute__((address_space(4))) CParams;
__device__ __forceinline__ CParams* kargs() { CParams* q = (CParams*)__builtin_amdgcn_kernarg_segment_ptr(); asm volatile("" : "+s"(q)); return q; }
#define PIN(i) (kargs()->in[i])
#define POUT (kargs()->out)
#define PWS (kargs()->ws)
struct Frame { LAS unsigned char* lds; int tid, lane, wave, G, gw, NGW, bid; };
__device__ __forceinline__ Frame make_frame(LAS unsigned char* lds) {
    Frame F; int tid = threadIdx.x; asm volatile("" : "+v"(tid));
    F.lds = lds; F.tid = tid; F.lane = tid & 63; F.wave = __builtin_amdgcn_readfirstlane(tid >> 6);
    int G = gridDim.x; asm volatile("" : "+s"(G));
    int bid = blockIdx.x; asm volatile("" : "+s"(bid));
    F.G = G; F.bid = bid; F.gw = bid * NWAVES + F.wave; F.NGW = F.G * NWAVES; return F;
}

__device__ __forceinline__ void transpose_item(const float* W, int K, int N, bf16_t* WT, LAS float* scr, int item, int lane, const float* gain) {
    const int nblk = N / 64, kb = item / nblk, nb = item % nblk, k0 = 64 * kb, n0 = 64 * nb;
    const int lr = lane >> 4, lc = 4 * (lane & 15);
    f32x4 wv[16];
#pragma unroll
    for (int i = 0; i < 16; ++i) wv[i] = __builtin_nontemporal_load((const f32x4*)(W + (size_t)(k0 + 4 * i + lr) * N + n0 + lc));
#pragma unroll
    for (int i = 0; i < 16; ++i) { const int kk = 4 * i + lr; const float g = gain ? gain[k0 + kk] : 1.f;
        *(LAS f32x4*)(scr + kk * 64 + (lc ^ (8 * ((kk >> 3) & 3)))) = wv[i] * g; }
    LDS_WAIT();
    const int c = lane & 7, nl = lane >> 3, sw = 8 * (c & 3);
#pragma unroll
    for (int j = 0; j < 8; ++j) { const int n = nl + 8 * j; const LAS float* sp = scr + (8 * c) * 64 + (n ^ sw);
        u32x4 o; o.x = cvt_pk_bf16(sp[0 * 64], sp[1 * 64]); o.y = cvt_pk_bf16(sp[2 * 64], sp[3 * 64]); o.z = cvt_pk_bf16(sp[4 * 64], sp[5 * 64]); o.w = cvt_pk_bf16(sp[6 * 64], sp[7 * 64]);
        *(u32x4*)(WT + (size_t)(n0 + n) * K + k0 + 8 * c) = o; }
    LDS_WAIT();
}
__device__ __forceinline__ void convert_mat(const Frame& F, const float* W, int K, int N, bf16_t* WT, const float* gain = nullptr) {
    LAS float* scr = (LAS float*)(F.lds + F.wave * 16384);
    const int nitems = (K / 64) * (N / 64);
    for (int rep = 0; rep < REP_CONV; ++rep) for (int it = F.gw; it < nitems; it += F.NGW) transpose_item(W, K, N, WT, scr, it, F.lane, gain);
}
__device__ __forceinline__ void xcopy_rows(const Frame& F, const float* x, bf16_t* xb, float* ssq, int nrows) {
    for (int r = F.gw; r < nrows; r += F.NGW) {
        const f32x4* xr = (const f32x4*)(x + (size_t)r * DM) + F.lane;
        f32x4 v[8]; float s2 = 0.f;
#pragma unroll
        for (int j = 0; j < 8; ++j) { v[j] = __builtin_nontemporal_load(xr + 64 * j); s2 += (v[j].x * v[j].x + v[j].y * v[j].y) + (v[j].z * v[j].z + v[j].w * v[j].w); }
        s2 = wave_sum(s2);
        u32x2* o = (u32x2*)(xb + (size_t)r * DM) + F.lane;
#pragma unroll
        for (int j = 0; j < 8; ++j) { u32x2 w; w.x = cvt_pk_bf16(v[j].x, v[j].y); w.y = cvt_pk_bf16(v[j].z, v[j].w); o[64 * j] = w; }
        if (F.lane < 8) ssq[(size_t)r * 8 + F.lane] = (F.lane == 0) ? s2 : 0.f;
    }
}

__device__ __forceinline__ void norm_rows(const Frame& F, const float* x, const float* gain, bf16_t* out, int nrows) {
    f32x4 gv[8];
#pragma unroll
    for (int j = 0; j < 8; ++j) gv[j] = gain ? ((const f32x4*)gain)[F.lane + 64 * j] : (f32x4){1.f, 1.f, 1.f, 1.f};
    for (int r = F.gw; r < nrows; r += F.NGW) {
        const f32x4* xr = (const f32x4*)(x + (size_t)r * DM) + F.lane;
        f32x4 v[8]; float s = 0.f;
#pragma unroll
        for (int j = 0; j < 8; ++j) { v[j] = xr[64 * j]; s += (v[j].x * v[j].x + v[j].y * v[j].y) + (v[j].z * v[j].z + v[j].w * v[j].w); }
        const float rstd = rsqrtf(wave_sum(s) * (1.f / DM) + EPS);
        u32x2* o = (u32x2*)(out + (size_t)r * DM) + F.lane;
#pragma unroll
        for (int j = 0; j < 8; ++j) { u32x2 w; w.x = cvt_pk_bf16(v[j].x * rstd * gv[j].x, v[j].y * rstd * gv[j].y); w.y = cvt_pk_bf16(v[j].z * rstd * gv[j].z, v[j].w * rstd * gv[j].w); o[64 * j] = w; }
    }
}

template <int RED, bool NORM>
__device__ __forceinline__ void post_pair(const bf16_t* s1, const bf16_t* s2, bf16_t* d1, bf16_t* d2, const float* g1, const float* g2, const float* ct, const float* st, bool rope, float inv_n, float scale, bool active) {
    float a[8], b[8];
    if (active) { ld8(s1, a); ld8(s2, b); } else {
#pragma unroll
        for (int k = 0; k < 8; ++k) { a[k] = 0.f; b[k] = 0.f; } }
    if (NORM) {
        float ss = 0.f;
#pragma unroll
        for (int k = 0; k < 8; ++k) ss += a[k] * a[k] + b[k] * b[k];
#pragma unroll
        for (int o = 1; o < RED; o <<= 1) ss += __shfl_xor(ss, o);
        const float rs = rsqrtf(ss * inv_n + EPS) * scale;
        if (active) {
#pragma unroll
            for (int k = 0; k < 8; ++k) { a[k] *= rs * g1[k]; b[k] *= rs * g2[k]; } }
    } else {
#pragma unroll
        for (int k = 0; k < 8; ++k) { a[k] *= scale; b[k] *= scale; }
    }
    if (active) {
        if (rope) {
#pragma unroll
            for (int k = 0; k < 8; ++k) { const float c = ct[k], s = st[k], na = a[k] * c - b[k] * s, nb = a[k] * s + b[k] * c; a[k] = na; b[k] = nb; } }
        st8(d1, a); st8(d2, b);
    }
}

struct PItem { const bf16_t* s1; const bf16_t* s2; bf16_t* d1; bf16_t* d2; const float* g1; const float* g2; const float* ct; const float* st; float scale; bool rope, active; };
template <int RED, bool NORM, int U, class MK>
__device__ __forceinline__ void post_loop(long gtid0, long nth, long total, float inv_n, MK mk) {
    for (long g0 = gtid0; g0 < total; g0 += nth * U) {
        PItem it[U]; float a[U][8], b[U][8];
#pragma unroll
        for (int u = 0; u < U; ++u) { const long gt = g0 + u * nth; const bool ok = gt < total; it[u] = mk(ok ? gt : g0); it[u].active = it[u].active && ok;
            if (it[u].active) { ld8(it[u].s1, a[u]); ld8(it[u].s2, b[u]); } else {
#pragma unroll
                for (int k = 0; k < 8; ++k) { a[u][k] = 0.f; b[u][k] = 0.f; } } }
#pragma unroll
        for (int u = 0; u < U; ++u) {
            float rs = it[u].scale;
            if (NORM) { float ss = 0.f;
#pragma unroll
                for (int k = 0; k < 8; ++k) ss += a[u][k] * a[u][k] + b[u][k] * b[u][k];
#pragma unroll
                for (int o = 1; o < RED; o <<= 1) ss += __shfl_xor(ss, o);
                rs *= rsqrtf(ss * inv_n + EPS); }
            if (it[u].active) {
#pragma unroll
                for (int k = 0; k < 8; ++k) { a[u][k] *= NORM ? rs * it[u].g1[k] : rs; b[u][k] *= NORM ? rs * it[u].g2[k] : rs; }
                if (it[u].rope) {
#pragma unroll
                    for (int k = 0; k < 8; ++k) { const float c = it[u].ct[k], sn = it[u].st[k], na = a[u][k] * c - b[u][k] * sn, nb = a[u][k] * sn + b[u][k] * c; a[u][k] = na; b[u][k] = nb; } }
                st8(it[u].d1, a[u]); st8(it[u].d2, b[u]);
            }
        }
    }
}

template <int LANES>
__device__ __forceinline__ void combine_rows(const Frame& F, const bf16_t* A, int lda, const bf16_t* B, const bf16_t* gate, int ldg, const float* gain, bf16_t* dst, int ldd, int heads, long nvec) {
    constexpr int HD = 16 * LANES;
    const long nth = (long)F.G * NTHREADS;
    for (long gt = (long)F.bid * NTHREADS + F.tid; gt < nvec * LANES; gt += nth) {
        const long hv = gt / LANES; const int j = (int)(gt % LANES); const long t = hv / heads; const int h = (int)(hv % heads); const int e0 = h * HD + 16 * j;
        float a[16], gt_[16];
        { float t0[8], t1[8]; ld8(A + t * lda + e0, t0); ld8(A + t * lda + e0 + 8, t1);
#pragma unroll
          for (int k = 0; k < 8; ++k) { a[k] = t0[k]; a[8 + k] = t1[k]; } }
        if (B) { float t0[8], t1[8]; ld8(B + t * lda + e0, t0); ld8(B + t * lda + e0 + 8, t1);
#pragma unroll
          for (int k = 0; k < 8; ++k) { a[k] += t0[k]; a[8 + k] += t1[k]; } }
        { float t0[8], t1[8]; ld8(gate + t * ldg + e0, t0); ld8(gate + t * ldg + e0 + 8, t1);
#pragma unroll
          for (int k = 0; k < 8; ++k) { gt_[k] = t0[k]; gt_[8 + k] = t1[k]; } }
        float ss = 0.f;
#pragma unroll
        for (int k = 0; k < 16; ++k) ss += a[k] * a[k];
#pragma unroll
        for (int o = 1; o < LANES; o <<= 1) ss += __shfl_xor(ss, o);
        const float rs = rsqrtf(ss * (1.f / HD) + EPS);
        float o0[8], o1[8];
#pragma unroll
        for (int k = 0; k < 8; ++k) { const float g0 = gt_[k], g1 = gt_[8 + k];
            o0[k] = a[k] * rs * gain[16 * j + k] * (g0 * sigmoidf_(g0)); o1[k] = a[8 + k] * rs * gain[16 * j + 8 + k] * (g1 * sigmoidf_(g1)); }
        st8(dst + t * ldd + e0, o0); st8(dst + t * ldd + e0 + 8, o1);
    }
}

#define KSWZ(row, colB, ROWB) ((row) * (ROWB) + ((colB) ^ (((row) & 7) << 4)))
__device__ __forceinline__ int crow(int r, int hi) { return (r & 3) + 8 * (r >> 2) + 4 * hi; }
__device__ __forceinline__ int v_st(int k, int c) { const int kk = (k & ~0xC) | ((k & 4) << 1) | ((k & 8) >> 1); return ((kk >> 3) * 4 + (c >> 5)) * 512 + ((kk & 7) * 32 + (c & 31)) * 2; }
__device__ __forceinline__ int v_rd_base(int lane) { return ((lane & 3) << 3) | (((lane >> 2) & 3) << 6) | (((lane >> 4) & 1) << 5) | (((lane >> 5) & 1) << 8); }
constexpr int v_rd_off(int d0, int ks, int half) { return d0 * 512 + ks * 4096 + half * 2048; }
template <int OFF> __device__ __forceinline__ s16x4 tr_read(int vb) { s16x4 r; asm volatile("ds_read_b64_tr_b16 %0, %1 offset:%2" : "=&v"(r) : "v"(vb), "i"(OFF) : "memory"); return r; }
template <int D0> __device__ __forceinline__ void pv_one(f32x16& od, int vb, bf16x8 pa0, bf16x8 pa1, bf16x8 pa2, bf16x8 pa3) {
    const s16x4 l0 = tr_read<v_rd_off(D0, 0, 0)>(vb), h0 = tr_read<v_rd_off(D0, 0, 1)>(vb), l1 = tr_read<v_rd_off(D0, 1, 0)>(vb), h1 = tr_read<v_rd_off(D0, 1, 1)>(vb);
    const s16x4 l2 = tr_read<v_rd_off(D0, 2, 0)>(vb), h2 = tr_read<v_rd_off(D0, 2, 1)>(vb), l3 = tr_read<v_rd_off(D0, 3, 0)>(vb), h3 = tr_read<v_rd_off(D0, 3, 1)>(vb);
    asm volatile("s_waitcnt lgkmcnt(0)" ::: "memory"); __builtin_amdgcn_sched_barrier(0);
#define PKV(L, H) (bf16x8){L[0], L[1], L[2], L[3], H[0], H[1], H[2], H[3]}
    od = __builtin_amdgcn_mfma_f32_32x32x16_bf16(pa0, PKV(l0, h0), od, 0, 0, 0);
    od = __builtin_amdgcn_mfma_f32_32x32x16_bf16(pa1, PKV(l1, h1), od, 0, 0, 0);
    od = __builtin_amdgcn_mfma_f32_32x32x16_bf16(pa2, PKV(l2, h2), od, 0, 0, 0);
    od = __builtin_amdgcn_mfma_f32_32x32x16_bf16(pa3, PKV(l3, h3), od, 0, 0, 0);
#undef PKV
}
template <int D0, int KS0> __device__ __forceinline__ void pv_half(f32x16& od, int vb, bf16x8 paA, bf16x8 paB) {
    const s16x4 l0 = tr_read<v_rd_off(D0, KS0, 0)>(vb), h0 = tr_read<v_rd_off(D0, KS0, 1)>(vb), l1 = tr_read<v_rd_off(D0, KS0 + 1, 0)>(vb), h1 = tr_read<v_rd_off(D0, KS0 + 1, 1)>(vb);
    asm volatile("s_waitcnt lgkmcnt(0)" ::: "memory"); __builtin_amdgcn_sched_barrier(0);
#define PKV(L, H) (bf16x8){L[0], L[1], L[2], L[3], H[0], H[1], H[2], H[3]}
    od = __builtin_amdgcn_mfma_f32_32x32x16_bf16(paA, PKV(l0, h0), od, 0, 0, 0);
    od = __builtin_amdgcn_mfma_f32_32x32x16_bf16(paB, PKV(l1, h1), od, 0, 0, 0);
#undef PKV
}
#define PK4(P, BASE, OUT) do { unsigned a0 = cvt_pk_bf16(P[BASE + 0], P[BASE + 1]), a1 = cvt_pk_bf16(P[BASE + 2], P[BASE + 3]);   \
    unsigned b0 = cvt_pk_bf16(P[BASE + 4], P[BASE + 5]), b1 = cvt_pk_bf16(P[BASE + 6], P[BASE + 7]);                              \
    auto r0 = __builtin_amdgcn_permlane32_swap(a0, b0, false, false); auto r1 = __builtin_amdgcn_permlane32_swap(a1, b1, false, false); \
    u32x4 w = {r0[0], r1[0], r0[1], r1[1]}; OUT = *reinterpret_cast<bf16x8*>(&w); } while (0)

template <int DK, int MODE, int QMODE>
__device__ __forceinline__ void attn_unit(const bf16_t* __restrict__ Qb, int ldq, const bf16_t* __restrict__ Kh, int ldk, const bf16_t* __restrict__ Vh, int ldv,
                                          bf16_t* __restrict__ Ob, int ldo, int nkeys, float C, float lgf2, float lgb2, int qpos0, LAS char* lds, const float* qg, const float* tcos, const float* tsin) {
    constexpr int ROWB = DK * 2, KTB = 64 * ROWB, NQ = DK / 16, KCH = DK / 64, CPR = DK / 8;
    int tid = threadIdx.x; asm volatile("" : "+v"(tid));
    const int wid = __builtin_amdgcn_readfirstlane(tid >> 6), lane = tid & 63, r32 = lane & 31, hi = lane >> 5;
    LAS char* V_lds = lds; LAS char* K_lds = lds + 3 * 16384;
    LAS float* wsf = (LAS float*)(lds + 3 * 16384 + 3 * KTB) + wid * 64; LAS float* li_l = wsf; LAS float* al_l = wsf + 32;
    float m_reg = -1e30f, l_reg = 0.f; f32x16 o[4];
#pragma unroll
    for (int d = 0; d < 4; ++d)
#pragma unroll
        for (int r = 0; r < 16; ++r) o[d][r] = 0.f;
    bf16x8 qr[NQ];
    { const bf16_t* Qw = Qb + (size_t)(wid * 32 + r32) * ldq + hi * 8;
#pragma unroll
      for (int d0 = 0; d0 < NQ; ++d0) qr[d0] = *(const bf16x8*)(Qw + d0 * 16); }
    if (QMODE != 0) {
#define Q_UNPK(D0, F) do { const u32x4 w4_ = *reinterpret_cast<const u32x4*>(&qr[D0]); F[0] = bf_lo(w4_.x); F[1] = bf_hi(w4_.x); F[2] = bf_lo(w4_.y); F[3] = bf_hi(w4_.y); F[4] = bf_lo(w4_.z); F[5] = bf_hi(w4_.z); F[6] = bf_lo(w4_.w); F[7] = bf_hi(w4_.w); } while (0)
#define Q_PACK(D0, F) do { u32x4 w4_; w4_.x = cvt_pk_bf16(F[0], F[1]); w4_.y = cvt_pk_bf16(F[2], F[3]); w4_.z = cvt_pk_bf16(F[4], F[5]); w4_.w = cvt_pk_bf16(F[6], F[7]); qr[D0] = *reinterpret_cast<bf16x8*>(&w4_); } while (0)
#define Q_GAIN(D0, F) do { const f32x4 g0_ = *(const f32x4*)(qg + (D0) * 16 + hi * 8), g1_ = *(const f32x4*)(qg + (D0) * 16 + hi * 8 + 4); _Pragma("unroll") for (int k = 0; k < 4; ++k) { F[k] *= rs * g0_[k]; F[4 + k] *= rs * g1_[k]; } } while (0)
        float ss = 0.f;
#pragma unroll
        for (int d0 = 0; d0 < NQ; ++d0) { float f[8]; Q_UNPK(d0, f);
#pragma unroll
            for (int k = 0; k < 8; ++k) ss += f[k] * f[k]; }
        ss += __shfl_xor(ss, 32);
        const float rs = rsqrtf(ss * (1.f / DK) + EPS);
        const int tpos = qpos0 + wid * 32 + r32;
#pragma unroll
        for (int d0 = 0; d0 < NQ; ++d0) {
            const bool first = (QMODE == 2) ? ((d0 & 2) == 0) : (QMODE == 3) ? (d0 == 8 || d0 == 9) : false;
            const bool second = (QMODE == 2) ? ((d0 & 2) != 0) : (QMODE == 3) ? (d0 == 10 || d0 == 11) : false;
            if (second) continue;
            float f[8]; Q_UNPK(d0, f); Q_GAIN(d0, f);
            if (first) { float f2[8]; Q_UNPK(d0 + 2, f2); Q_GAIN(d0 + 2, f2);
                const int dd = d0 & 1; const int pos = (QMODE == 2) ? ((d0 & 4) ? (tpos & 63) : (tpos >> 6)) : tpos;
                const float* cp = tcos + pos * 32 + dd * 16 + hi * 8; const float* sp = tsin + pos * 32 + dd * 16 + hi * 8;
#pragma unroll
                for (int k = 0; k < 8; ++k) { const float c = cp[k], sn = sp[k], x1 = f[k], x2 = f2[k]; f[k] = x1 * c - x2 * sn; f2[k] = x1 * sn + x2 * c; }
                Q_PACK(d0 + 2, f2); }
            Q_PACK(d0, f);
        }
#undef Q_UNPK
#undef Q_PACK
#undef Q_GAIN
    }
    const int vb0 = (int)(uintptr_t)V_lds + v_rd_base(lane);
    unsigned koff[KCH], voff[2];
#pragma unroll
    for (int i = 0; i < KCH; ++i) { const int p = (i * 8 + wid) * 64 + lane, row = p / CPR, cc = (p % CPR) ^ (row & 7); koff[i] = (unsigned)(row * ldk + cc * 8) * 2u; }
#pragma unroll
    for (int i = 0; i < 2; ++i) { const int p = (i * 8 + wid) * 64 + lane, sub = p >> 5, kk = (sub >> 2) * 8 + ((p & 31) >> 2), c = (sub & 3) * 32 + (p & 3) * 8;
        const int k = (kk & ~0xC) | ((kk & 4) << 1) | ((kk & 8) >> 1); voff[i] = (unsigned)(k * ldv + c) * 2u; }
#define A_DMA(k0, b) do { const char* kb_ = (const char*)(Kh + (size_t)(k0) * ldk); const char* vb_ = (const char*)(Vh + (size_t)(k0) * ldv); \
    _Pragma("unroll") for (int i = 0; i < KCH; ++i) __builtin_amdgcn_global_load_lds((const unsigned*)(kb_ + koff[i]), (LAS unsigned*)(K_lds + (b) * KTB + (i * 8 + wid) * 1024), 16, 0, 0); \
    _Pragma("unroll") for (int i = 0; i < 2; ++i) __builtin_amdgcn_global_load_lds((const unsigned*)(vb_ + voff[i]), (LAS unsigned*)(V_lds + (b) * 16384 + (i * 8 + wid) * 1024), 16, 0, 0); } while (0)
    const int NT = nkeys / 64;
    const float thr_raw = (MODE == 0) ? 8.0f * 1.4426950408889634f / C : 0.f;
#define A_BAR() do { asm volatile("s_waitcnt lgkmcnt(0)" ::: "memory"); __builtin_amdgcn_s_barrier(); asm volatile("" ::: "memory"); } while (0)
    A_DMA(0, 0);
    if (NT > 1) { A_DMA(64, 1); asm volatile("s_waitcnt vmcnt(%0)" :: "n"(KCH + 2) : "memory"); } else asm volatile("s_waitcnt vmcnt(0)" ::: "memory");
    A_BAR();
    int buf = 0;
    for (int j = 0; j < NT; ++j) {
        if (j + 2 < NT) A_DMA((j + 2) * 64, (buf == 0 ? 2 : buf - 1));
        __builtin_amdgcn_sched_barrier(0);
        LAS const char* Ks = K_lds + buf * KTB;
        bf16x8 pa0 = {}, pa1 = {}, pa2 = {}, pa3 = {};
        if (MODE == 0) {
            f32x16 p0, p1;
#pragma unroll
            for (int r = 0; r < 16; ++r) { p0[r] = 0.f; p1[r] = 0.f; }
#pragma unroll
            for (int d0 = 0; d0 < NQ; ++d0) { const int cb = (d0 * 16 + hi * 8) * 2;
                const bf16x8 b0 = *(LAS const bf16x8*)(Ks + KSWZ(r32, cb, ROWB));
                const bf16x8 b1 = *(LAS const bf16x8*)(Ks + KSWZ(32 + r32, cb, ROWB));
                p0 = __builtin_amdgcn_mfma_f32_32x32x16_bf16(b0, qr[d0], p0, 0, 0, 0);
                p1 = __builtin_amdgcn_mfma_f32_32x32x16_bf16(b1, qr[d0], p1, 0, 0, 0); }
            float pmax = p0[0];
#pragma unroll
            for (int r = 1; r < 16; ++r) pmax = fmaxf(pmax, p0[r]);
#pragma unroll
            for (int r = 0; r < 16; ++r) pmax = fmaxf(pmax, p1[r]);
            { auto rr = __builtin_amdgcn_permlane32_swap(__float_as_uint(pmax), __float_as_uint(pmax), false, false); pmax = fmaxf(__uint_as_float(rr[0]), __uint_as_float(rr[1])); }
            float alpha = 1.f;
            if (!__all(pmax - m_reg <= thr_raw)) { const float mn = fmaxf(m_reg, pmax); alpha = __builtin_amdgcn_exp2f((m_reg - mn) * C); m_reg = mn; }
            const float mnC = -m_reg * C;
#pragma unroll
            for (int r = 0; r < 16; ++r) { p0[r] = __builtin_amdgcn_exp2f(fmaf(p0[r], C, mnC)); p1[r] = __builtin_amdgcn_exp2f(fmaf(p1[r], C, mnC)); }
            float ps = 0.f;
#pragma unroll
            for (int r = 0; r < 16; ++r) ps += p0[r] + p1[r];
            { auto rr = __builtin_amdgcn_permlane32_swap(__float_as_uint(ps), __float_as_uint(ps), false, false); ps = __uint_as_float(rr[0]) + __uint_as_float(rr[1]); }
            l_reg = l_reg * alpha + ps;
            if (__any(alpha < 1.f)) { if (hi == 0) al_l[r32] = alpha; asm volatile("s_waitcnt lgkmcnt(0)" ::: "memory");
#pragma unroll
                for (int r = 0; r < 16; ++r) { const float al = al_l[crow(r, hi)];
#pragma unroll
                    for (int d = 0; d < 4; ++d) o[d][r] *= al; } }
            PK4(p0, 0, pa0); PK4(p0, 8, pa1); PK4(p1, 0, pa2); PK4(p1, 8, pa3);
        } else {
            const float tq = (float)(qpos0 + wid * 32 + r32 - 64 * j);
#pragma unroll
            for (int hh = 0; hh < 2; ++hh) {
                f32x16 p;
#pragma unroll
                for (int r = 0; r < 16; ++r) p[r] = 0.f;
#pragma unroll
                for (int d0 = 0; d0 < NQ; ++d0) { const int cb = (d0 * 16 + hi * 8) * 2;
                    if ((d0 & 3) == 0) __builtin_amdgcn_sched_barrier(0);
                    const bf16x8 b0 = *(LAS const bf16x8*)(Ks + KSWZ(32 * hh + r32, cb, ROWB));
                    p = __builtin_amdgcn_mfma_f32_32x32x16_bf16(b0, qr[d0], p, 0, 0, 0); }
#pragma unroll
                for (int r = 0; r < 16; ++r) {
                    const float dd = tq - (float)(crow(r, hi) + 32 * hh);
                    const float w = (dd == 0.f) ? 2.f : __builtin_amdgcn_exp2f(dd * (dd > 0.f ? lgf2 : -lgb2));
                    p[r] *= w; }
                bf16x8 paA, paB; PK4(p, 0, paA); PK4(p, 8, paB);
                const int vb = vb0 + buf * 16384;
                if (hh == 0) { pv_half<0, 0>(o[0], vb, paA, paB); pv_half<1, 0>(o[1], vb, paA, paB); pv_half<2, 0>(o[2], vb, paA, paB); pv_half<3, 0>(o[3], vb, paA, paB); }
                else         { pv_half<0, 2>(o[0], vb, paA, paB); pv_half<1, 2>(o[1], vb, paA, paB); pv_half<2, 2>(o[2], vb, paA, paB); pv_half<3, 2>(o[3], vb, paA, paB); }
            }
        }
        if (MODE == 0) { const int vb = vb0 + buf * 16384;
          pv_one<0>(o[0], vb, pa0, pa1, pa2, pa3); pv_one<1>(o[1], vb, pa0, pa1, pa2, pa3); pv_one<2>(o[2], vb, pa0, pa1, pa2, pa3); pv_one<3>(o[3], vb, pa0, pa1, pa2, pa3); }
        if (j + 2 < NT) asm volatile("s_waitcnt vmcnt(%0)" :: "n"(KCH + 2) : "memory"); else asm volatile("s_waitcnt vmcnt(0)" ::: "memory");
        A_BAR();
        buf = (buf == 2) ? 0 : buf + 1;
    }
    float rli[16];
    if (MODE == 0) {
        if (hi == 0) li_l[r32] = l_reg; asm volatile("s_waitcnt lgkmcnt(0)" ::: "memory");
#pragma unroll
        for (int r = 0; r < 16; ++r) rli[r] = __builtin_amdgcn_rcpf(li_l[crow(r, hi)]);
    } else {
#pragma unroll
        for (int r = 0; r < 16; ++r) rli[r] = 1.f;
    }
    bf16_t* Ow = Ob + (size_t)(wid * 32) * ldo;
#pragma unroll
    for (int r = 0; r < 16; ++r) { const int orow = crow(r, hi);
#pragma unroll
        for (int d0 = 0; d0 < 4; ++d0) { const float v = o[d0][r] * rli[r]; Ow[(size_t)orow * ldo + d0 * 32 + r32] = (bf16_t)(cvt_pk_bf16(v, v) & 0xffffu); } }
#undef A_DMA
#undef A_BAR
}

template <int DK, int MODE, int QMODE>
__device__ __forceinline__ void attn_phase(const Frame& F, const bf16_t* Q, int ldq, int qhs, const bf16_t* K, int ldk, int khs, const bf16_t* V, int ldv, int vhs, bf16_t* O, int ldo, int ohs,
                                           int nb, int nheads, int gq, int nslice, int sq, int skv, float C, const float* decay, const float* qg, const float* tcos, const float* tsin) {
    const int nqb = sq / 256, units = nb * nheads * nslice * nqb;
    const int vcu = (F.G % 8 == 0) ? (F.bid % 8) * (F.G / 8) + F.bid / 8 : F.bid;
    for (int u = vcu; u < units; u += F.G) {
        const int qb = u % nqb; int r = u / nqb; const int sl = r % nslice; r /= nslice; const int h = r % nheads; const int b = r / nheads; const int kvh = h / gq;
        float lgf2 = 0.f, lgb2 = 0.f;
        if (MODE == 1) { lgf2 = -log1pf(expf(-decay[h])) * 1.4426950408889634f; lgb2 = -log1pf(expf(-decay[8 + h])) * 1.4426950408889634f; }
        attn_unit<DK, MODE, QMODE>(Q + (size_t)(b * sq + qb * 256) * ldq + h * qhs, ldq, K + (size_t)(b * skv) * ldk + kvh * khs, ldk, V + (size_t)(b * skv) * ldv + kvh * vhs + sl * 128, ldv,
                            O + (size_t)(b * sq + qb * 256) * ldo + h * ohs + sl * 128, ldo, skv, C, lgf2, lgb2, qb * 256, (LAS char*)F.lds, qg, tcos, tsin);
        __syncthreads();
    }
}

__device__ __forceinline__ unsigned off_b(unsigned row, unsigned ch) { return 256u * row + 16u * (ch ^ (((row & 3) << 2) | ((row >> 2) & 3))); }
__device__ __forceinline__ unsigned rr16(unsigned lane, unsigned rb, unsigned s) { return off_b((lane & 15) + 16 * rb, 4 * s + (lane >> 4)); }
__device__ __forceinline__ unsigned tr16(unsigned lane, unsigned c, unsigned t) { const unsigned g = lane >> 4, q = (lane & 15) >> 2, p = lane & 3; return off_b(8 * g + 4 * t + q, 2 * c + (p >> 1)) + 8 * (p & 1); }
__device__ __forceinline__ s16x4 tr_rd(unsigned addr) { return __builtin_amdgcn_ds_read_tr16_b64_v4i16((LAS s16x4*)(uintptr_t)addr); }
#define TRWAIT() do { } while (0)
#define PK2T(L, H) (bf16x8){L[0], L[1], L[2], L[3], H[0], H[1], H[2], H[3]}

__device__ __forceinline__ void hg_scan_item(const Frame& F, const bf16_t* big, const float* hg_lb, bf16_t* outp, int b, int h, int dir) {
    constexpr unsigned O_QT = 0, O_KT = 8192, O_KS = 16384, O_VV = 24576, O_ST = 40960, O_SS = 73728, O_TOT = 75776, O_EBL = 79872;
    constexpr int NCH = SEQ / 32;
    LAS char* L = (LAS char*)F.lds;
    int tid = F.tid; asm volatile("" : "+v"(tid));
    const int lane = tid & 63, w = __builtin_amdgcn_readfirstlane(tid >> 6), fq = lane >> 4, fr = lane & 15;
    const int et_ = tid >> 4, c8 = tid & 15, tl = lane >> 4;
    const unsigned lbase = (unsigned)(uintptr_t)L;
    float lb8[8];
#pragma unroll
    for (int k = 0; k < 8; ++k) { const int d = h * 128 + 8 * c8 + k; const float l0 = hg_lb[d], l1 = hg_lb[2048 + d], l2 = hg_lb[4096 + d], l3 = hg_lb[6144 + d];
        const float mx = fmaxf(fmaxf(l0, l1), fmaxf(l2, l3)); const float e0 = expf(l0 - mx), e1 = expf(l1 - mx), e2 = expf(l2 - mx), e3 = expf(l3 - mx);
        lb8[k] = e1 / (e0 + e1 + e2 + e3); }
#pragma unroll
    for (int i = 0; i < 4; ++i) *(LAS u32x4*)(L + O_ST + (tid + 512 * i) * 16) = (u32x4){0u, 0u, 0u, 0u};
    f32x4 S[8];
#pragma unroll
    for (int i = 0; i < 8; ++i) S[i] = (f32x4){0.f, 0.f, 0.f, 0.f};
    const size_t rowbase = (size_t)b * SEQ;
    const int colq = h * 128 + 8 * c8, colf = 2048 + dir * 2048 + h * 128 + 8 * c8;
    const int vrow = 4 * w + tl; const int vch = fr ^ (((vrow & 3) << 2) | ((vrow >> 2) & 3)); const int colv = 6144 + h * 128 + 8 * vch;
#define HG_BAR() do { asm volatile("s_waitcnt lgkmcnt(0)" ::: "memory"); __builtin_amdgcn_s_barrier(); asm volatile("" ::: "memory"); } while (0)
#define HG_TOK(p) (dir ? (SEQ - 1 - (p)) : (p))
#define HG_LOADQF(c) do { const bf16_t* row_ = big + (rowbase + HG_TOK((c) * 32 + et_)) * 10240; qv = *(const u32x4*)(row_ + colq); fv = *(const u32x4*)(row_ + colf); } while (0)
#define HG_DMAV(c, buf) __builtin_amdgcn_global_load_lds((const unsigned*)(big + (rowbase + HG_TOK((c) * 32 + vrow)) * 10240 + colv), (LAS unsigned*)(L + O_VV + (buf) * 8192 + w * 1024), 16, 0, 0)
    u32x4 qv, fv; float q8[8], f8[8], x8[8];
#define HG_E1() do { float fz_[8]; fz_[0] = bf_lo(fv.x); fz_[1] = bf_hi(fv.x); fz_[2] = bf_lo(fv.y); fz_[3] = bf_hi(fv.y); fz_[4] = bf_lo(fv.z); fz_[5] = bf_hi(fv.z); fz_[6] = bf_lo(fv.w); fz_[7] = bf_hi(fv.w); \
        q8[0] = bf_lo(qv.x); q8[1] = bf_hi(qv.x); q8[2] = bf_lo(qv.y); q8[3] = bf_hi(qv.y); q8[4] = bf_lo(qv.z); q8[5] = bf_hi(qv.z); q8[6] = bf_lo(qv.w); q8[7] = bf_hi(qv.w); \
        _Pragma("unroll") for (int k = 0; k < 8; ++k) { f8[k] = lb8[k] + (1.f - lb8[k]) * sigmoidf_(fz_[k]); x8[k] = f8[k]; } \
        _Pragma("unroll") for (int k = 0; k < 8; ++k) { const float y_ = __shfl_up(x8[k], 16); x8[k] = (tl >= 1) ? x8[k] * y_ : x8[k]; } \
        _Pragma("unroll") for (int k = 0; k < 8; ++k) { const float y_ = __shfl_up(x8[k], 32); x8[k] = (tl >= 2) ? x8[k] * y_ : x8[k]; } \
        if (tl == 3) { *(LAS f32x4*)(L + O_TOT + (w * 128 + 8 * c8) * 4) = (f32x4){x8[0], x8[1], x8[2], x8[3]}; *(LAS f32x4*)(L + O_TOT + (w * 128 + 8 * c8 + 4) * 4) = (f32x4){x8[4], x8[5], x8[6], x8[7]}; } } while (0)
    HG_LOADQF(0); HG_DMAV(0, 0);
    HG_E1(); asm volatile("s_waitcnt vmcnt(0)" ::: "memory");
    for (int c = 0; c < NCH; ++c) {
        const int buf = c & 1;
        asm volatile("s_waitcnt vmcnt(2)" ::: "memory");
        HG_BAR();
        if (c > 0) {
#pragma unroll
            for (int et = 0; et < 8; ++et) { u32x2 v2; v2.x = cvt_pk_bf16(S[et][0], S[et][1]); v2.y = cvt_pk_bf16(S[et][2], S[et][3]);
                *(LAS u32x2*)(L + O_ST + off_b(16 * et + fr, 2 * w + (fq >> 1)) + 8 * (fq & 1)) = v2; }
        }
        {
            float pre[8], all[8];
#pragma unroll
            for (int k = 0; k < 8; ++k) { pre[k] = 1.f; all[k] = 1.f; }
#pragma unroll
            for (int w2 = 0; w2 < 8; ++w2) { const f32x4 t0 = *(LAS const f32x4*)(L + O_TOT + (w2 * 128 + 8 * c8) * 4), t1 = *(LAS const f32x4*)(L + O_TOT + (w2 * 128 + 8 * c8 + 4) * 4);
#pragma unroll
                for (int k = 0; k < 4; ++k) { all[k] *= t0[k]; all[4 + k] *= t1[k]; if (w2 < w) { pre[k] *= t0[k]; pre[4 + k] *= t1[k]; } } }
            float qt[8], kt[8], ks[8];
#pragma unroll
            for (int k = 0; k < 8; ++k) { const float eb = x8[k] * pre[k]; qt[k] = q8[k] * eb; kt[k] = (1.f - f8[k]) * __builtin_amdgcn_rcpf(eb); ks[k] = kt[k] * all[k]; }
            const unsigned o = off_b(et_, c8);
            u32x4 wv; wv.x = cvt_pk_bf16(qt[0], qt[1]); wv.y = cvt_pk_bf16(qt[2], qt[3]); wv.z = cvt_pk_bf16(qt[4], qt[5]); wv.w = cvt_pk_bf16(qt[6], qt[7]); *(LAS u32x4*)(L + O_QT + o) = wv;
            wv.x = cvt_pk_bf16(kt[0], kt[1]); wv.y = cvt_pk_bf16(kt[2], kt[3]); wv.z = cvt_pk_bf16(kt[4], kt[5]); wv.w = cvt_pk_bf16(kt[6], kt[7]); *(LAS u32x4*)(L + O_KT + o) = wv;
            wv.x = cvt_pk_bf16(ks[0], ks[1]); wv.y = cvt_pk_bf16(ks[2], ks[3]); wv.z = cvt_pk_bf16(ks[4], ks[5]); wv.w = cvt_pk_bf16(ks[6], ks[7]); *(LAS u32x4*)(L + O_KS + o) = wv;
            if (tid < 16) { *(LAS f32x4*)(L + O_EBL + (8 * c8) * 4) = (f32x4){all[0], all[1], all[2], all[3]}; *(LAS f32x4*)(L + O_EBL + (8 * c8 + 4) * 4) = (f32x4){all[4], all[5], all[6], all[7]}; }
        }
        if (c + 1 < NCH) { HG_LOADQF(c + 1); HG_DMAV(c + 1, buf ^ 1); }
        HG_BAR();
        if (w < 4) {
            const int jt = w >> 1, it = w & 1; f32x4 a = {0.f, 0.f, 0.f, 0.f};
#pragma unroll
            for (int s4 = 0; s4 < 4; ++s4) { const bf16x8 xk = *(LAS const bf16x8*)(L + O_KT + rr16(lane, jt, s4)), yq = *(LAS const bf16x8*)(L + O_QT + rr16(lane, it, s4));
                a = __builtin_amdgcn_mfma_f32_16x16x32_bf16(xk, yq, a, 0, 0, 0); }
            const int ig = 16 * it + fr, jg = 16 * jt + 4 * fq;
#pragma unroll
            for (int r = 0; r < 4; ++r) a[r] = (jg + r <= ig) ? a[r] : 0.f;
            u32x2 v2; v2.x = cvt_pk_bf16(a[0], a[1]); v2.y = cvt_pk_bf16(a[2], a[3]);
            *(LAS u32x2*)(L + O_SS + ig * 64 + jg * 2) = v2;
        }
        HG_BAR();
        {
            const unsigned vb = lbase + O_VV + buf * 8192;
            const s16x4 v0 = tr_rd(vb + tr16(lane, w, 0)), v1 = tr_rd(vb + tr16(lane, w, 1));
            bf16x8 xd[4];
#pragma unroll
            for (int s4 = 0; s4 < 4; ++s4) xd[s4] = *(LAS const bf16x8*)(L + O_ST + rr16(lane, w, s4));
            TRWAIT();
            const bf16x8 xs = PK2T(v0, v1);
#pragma unroll
            for (int it = 0; it < 2; ++it) {
                const bf16x8 ys = *(LAS const bf16x8*)(L + O_SS + (16 * it + fr) * 64 + fq * 16);
                f32x4 a = {0.f, 0.f, 0.f, 0.f};
                a = __builtin_amdgcn_mfma_f32_16x16x32_bf16(xs, ys, a, 0, 0, 0);
#pragma unroll
                for (int s4 = 0; s4 < 4; ++s4) { const bf16x8 yq = *(LAS const bf16x8*)(L + O_QT + rr16(lane, it, s4)); a = __builtin_amdgcn_mfma_f32_16x16x32_bf16(xd[s4], yq, a, 0, 0, 0); }
                u32x2 v2; v2.x = cvt_pk_bf16(a[0], a[1]); v2.y = cvt_pk_bf16(a[2], a[3]);
                *(u32x2*)(outp + (rowbase + HG_TOK(c * 32 + 16 * it + fr)) * 2048 + h * 128 + 16 * w + 4 * fq) = v2;
            }
        }
        {
            const unsigned vb = lbase + O_VV + buf * 8192, kb = lbase + O_KS;
            const s16x4 k0 = tr_rd(kb + tr16(lane, w, 0)), k1 = tr_rd(kb + tr16(lane, w, 1));
            const f32x4 e4 = *(LAS const f32x4*)(L + O_EBL + (16 * w + 4 * fq) * 4);
            TRWAIT();
            const bf16x8 xk = PK2T(k0, k1);
#pragma unroll
            for (int hb = 0; hb < 2; ++hb) {
                s16x4 va[4], vc[4];
#pragma unroll
                for (int e4i = 0; e4i < 4; ++e4i) { va[e4i] = tr_rd(vb + tr16(lane, 4 * hb + e4i, 0)); vc[e4i] = tr_rd(vb + tr16(lane, 4 * hb + e4i, 1)); }
                TRWAIT();
#pragma unroll
                for (int e4i = 0; e4i < 4; ++e4i) { const int et = 4 * hb + e4i; S[et] = S[et] * e4; S[et] = __builtin_amdgcn_mfma_f32_16x16x32_bf16(xk, PK2T(va[e4i], vc[e4i]), S[et], 0, 0, 0); }
            }
        }
        if (c + 1 < NCH) HG_E1();
    }
    asm volatile("s_waitcnt vmcnt(0)" ::: "memory");
    __syncthreads();
#undef HG_TOK
#undef HG_BAR
#undef HG_LOADQF
#undef HG_DMAV
#undef HG_E1
}

__device__ __forceinline__ void hg_scan2_item(const Frame& F, const bf16_t* big, const float* hg_lb, bf16_t* outp, int b, int h, int dir) {
    constexpr unsigned O_QT = 0, O_KT = 16384, O_KS = 32768, O_VV = 49152, O_SS = 81920, O_TOT = 86016, O_EBL = 94208;
    constexpr int NIT = SEQ / 64;
    LAS char* L = (LAS char*)F.lds;
    int tid = F.tid; asm volatile("" : "+v"(tid));
    const int lane = tid & 63, w = __builtin_amdgcn_readfirstlane(tid >> 6), fq = lane >> 4, fr = lane & 15;
    const int et_ = tid >> 4, c8 = tid & 15, tl = lane >> 4;
    const unsigned lbase = (unsigned)(uintptr_t)L;
    float lb8[8];
#pragma unroll
    for (int k = 0; k < 8; ++k) { const int d = h * 128 + 8 * c8 + k; const float l0 = hg_lb[d], l1 = hg_lb[2048 + d], l2 = hg_lb[4096 + d], l3 = hg_lb[6144 + d];
        const float mx = fmaxf(fmaxf(l0, l1), fmaxf(l2, l3)); const float e0 = expf(l0 - mx), e1 = expf(l1 - mx), e2 = expf(l2 - mx), e3 = expf(l3 - mx);
        lb8[k] = e1 / (e0 + e1 + e2 + e3); }
    f32x4 S[8];
#pragma unroll
    for (int i = 0; i < 8; ++i) S[i] = (f32x4){0.f, 0.f, 0.f, 0.f};
    const size_t rowbase = (size_t)b * SEQ;
    const int colq = h * 128 + 8 * c8, colf = 2048 + dir * 2048 + h * 128 + 8 * c8;
    const int vrow = 4 * w + tl; const int vch = fr ^ (((vrow & 3) << 2) | ((vrow >> 2) & 3)); const int colv = 6144 + h * 128 + 8 * vch;
#define H2_BAR() do { asm volatile("s_waitcnt lgkmcnt(0)" ::: "memory"); __builtin_amdgcn_s_barrier(); asm volatile("" ::: "memory"); } while (0)
#define H2_TOK(p) (dir ? (SEQ - 1 - (p)) : (p))
#define H2_LOADQF(c) do { _Pragma("unroll") for (int sb_ = 0; sb_ < 2; ++sb_) { const bf16_t* row_ = big + (rowbase + H2_TOK((c) * 64 + 32 * sb_ + et_)) * 10240; qv[sb_] = *(const u32x4*)(row_ + colq); fv[sb_] = *(const u32x4*)(row_ + colf); } } while (0)
#define H2_DMAV(c, buf) do { _Pragma("unroll") for (int sb_ = 0; sb_ < 2; ++sb_) \
        __builtin_amdgcn_global_load_lds((const unsigned*)(big + (rowbase + H2_TOK((c) * 64 + 32 * sb_ + vrow)) * 10240 + colv), (LAS unsigned*)(L + O_VV + (buf) * 16384 + sb_ * 8192 + w * 1024), 16, 0, 0); } while (0)
    u32x4 qv[2], fv[2]; float q8[2][8], f8[2][8], x8[2][8];
#define H2_E1() do { _Pragma("unroll") for (int sb_ = 0; sb_ < 2; ++sb_) { float fz_[8]; const u32x4 fw_ = fv[sb_], qw_ = qv[sb_]; \
        fz_[0] = bf_lo(fw_.x); fz_[1] = bf_hi(fw_.x); fz_[2] = bf_lo(fw_.y); fz_[3] = bf_hi(fw_.y); fz_[4] = bf_lo(fw_.z); fz_[5] = bf_hi(fw_.z); fz_[6] = bf_lo(fw_.w); fz_[7] = bf_hi(fw_.w); \
        q8[sb_][0] = bf_lo(qw_.x); q8[sb_][1] = bf_hi(qw_.x); q8[sb_][2] = bf_lo(qw_.y); q8[sb_][3] = bf_hi(qw_.y); q8[sb_][4] = bf_lo(qw_.z); q8[sb_][5] = bf_hi(qw_.z); q8[sb_][6] = bf_lo(qw_.w); q8[sb_][7] = bf_hi(qw_.w); \
        _Pragma("unroll") for (int k = 0; k < 8; ++k) { f8[sb_][k] = lb8[k] + (1.f - lb8[k]) * sigmoidf_(fz_[k]); x8[sb_][k] = f8[sb_][k]; } \
        _Pragma("unroll") for (int k = 0; k < 8; ++k) { const float y_ = __shfl_up(x8[sb_][k], 16); x8[sb_][k] = (tl >= 1) ? x8[sb_][k] * y_ : x8[sb_][k]; } \
        _Pragma("unroll") for (int k = 0; k < 8; ++k) { const float y_ = __shfl_up(x8[sb_][k], 32); x8[sb_][k] = (tl >= 2) ? x8[sb_][k] * y_ : x8[sb_][k]; } \
        if (tl == 3) { *(LAS f32x4*)(L + O_TOT + sb_ * 4096 + (w * 128 + 8 * c8) * 4) = (f32x4){x8[sb_][0], x8[sb_][1], x8[sb_][2], x8[sb_][3]}; \
                       *(LAS f32x4*)(L + O_TOT + sb_ * 4096 + (w * 128 + 8 * c8 + 4) * 4) = (f32x4){x8[sb_][4], x8[sb_][5], x8[sb_][6], x8[sb_][7]}; } } } while (0)
    H2_LOADQF(0); H2_DMAV(0, 0);
    H2_E1(); asm volatile("s_waitcnt vmcnt(0)" ::: "memory");
    for (int c = 0; c < NIT; ++c) {
        const int buf = c & 1;
        asm volatile("s_waitcnt vmcnt(4)" ::: "memory");
        H2_BAR();
        if (c + 1 < NIT) { H2_LOADQF(c + 1); H2_DMAV(c + 1, buf ^ 1); }
#pragma unroll
        for (int sb = 0; sb < 2; ++sb) {
            __builtin_amdgcn_sched_barrier(0);
            float pre[8], all[8];
            { f32x4 t[8][2];
#pragma unroll
              for (int w2 = 0; w2 < 8; ++w2) { t[w2][0] = *(LAS const f32x4*)(L + O_TOT + sb * 4096 + (w2 * 128 + 8 * c8) * 4); t[w2][1] = *(LAS const f32x4*)(L + O_TOT + sb * 4096 + (w2 * 128 + 8 * c8 + 4) * 4); }
#pragma unroll
              for (int hh = 0; hh < 2; ++hh) {
                  const f32x4 p01 = t[0][hh] * t[1][hh], p23 = t[2][hh] * t[3][hh], p45 = t[4][hh] * t[5][hh], p67 = t[6][hh] * t[7][hh], p03 = p01 * p23, p47 = p45 * p67, pall = p03 * p47;
                  f32x4 pw;
                  if (w == 0) pw = (f32x4){1.f, 1.f, 1.f, 1.f}; else if (w == 1) pw = t[0][hh]; else if (w == 2) pw = p01; else if (w == 3) pw = p01 * t[2][hh];
                  else if (w == 4) pw = p03; else if (w == 5) pw = p03 * t[4][hh]; else if (w == 6) pw = p03 * p45; else pw = p03 * p45 * t[6][hh];
#pragma unroll
                  for (int k = 0; k < 4; ++k) { pre[4 * hh + k] = pw[k]; all[4 * hh + k] = pall[k]; } } }
            float qt[8], kt[8], ks[8];
#pragma unroll
            for (int k = 0; k < 8; ++k) { const float eb = x8[sb][k] * pre[k]; qt[k] = q8[sb][k] * eb; kt[k] = (1.f - f8[sb][k]) * __builtin_amdgcn_rcpf(eb); ks[k] = kt[k] * all[k]; }
            const unsigned o = off_b(32 * sb + et_, c8);
            u32x4 wv; wv.x = cvt_pk_bf16(qt[0], qt[1]); wv.y = cvt_pk_bf16(qt[2], qt[3]); wv.z = cvt_pk_bf16(qt[4], qt[5]); wv.w = cvt_pk_bf16(qt[6], qt[7]); *(LAS u32x4*)(L + O_QT + o) = wv;
            wv.x = cvt_pk_bf16(kt[0], kt[1]); wv.y = cvt_pk_bf16(kt[2], kt[3]); wv.z = cvt_pk_bf16(kt[4], kt[5]); wv.w = cvt_pk_bf16(kt[6], kt[7]); *(LAS u32x4*)(L + O_KT + o) = wv;
            wv.x = cvt_pk_bf16(ks[0], ks[1]); wv.y = cvt_pk_bf16(ks[2], ks[3]); wv.z = cvt_pk_bf16(ks[4], ks[5]); wv.w = cvt_pk_bf16(ks[6], ks[7]); *(LAS u32x4*)(L + O_KS + o) = wv;
            if (tid < 16) { *(LAS f32x4*)(L + O_EBL + sb * 512 + (8 * c8) * 4) = (f32x4){all[0], all[1], all[2], all[3]}; *(LAS f32x4*)(L + O_EBL + sb * 512 + (8 * c8 + 4) * 4) = (f32x4){all[4], all[5], all[6], all[7]}; }
        }
        H2_BAR();
        {
            const int sb = w >> 2, jt = (w >> 1) & 1, it = w & 1; f32x4 a = {0.f, 0.f, 0.f, 0.f};
#pragma unroll
            for (int s4 = 0; s4 < 4; ++s4) { const bf16x8 xk = *(LAS const bf16x8*)(L + O_KT + rr16(lane, 2 * sb + jt, s4)), yq = *(LAS const bf16x8*)(L + O_QT + rr16(lane, 2 * sb + it, s4));
                a = __builtin_amdgcn_mfma_f32_16x16x32_bf16(xk, yq, a, 0, 0, 0); }
            const int ig = 16 * it + fr, jg = 16 * jt + 4 * fq;
#pragma unroll
            for (int r = 0; r < 4; ++r) a[r] = (jg + r <= ig) ? a[r] : 0.f;
            u32x2 v2; v2.x = cvt_pk_bf16(a[0], a[1]); v2.y = cvt_pk_bf16(a[2], a[3]);
            *(LAS u32x2*)(L + O_SS + sb * 2048 + ig * 64 + jg * 2) = v2;
        }
        H2_BAR();
#pragma unroll
        for (int sb = 0; sb < 2; ++sb) {
            __builtin_amdgcn_sched_barrier(0);
            const unsigned vb = lbase + O_VV + buf * 16384 + sb * 8192;
            const s16x4 v0 = tr_rd(vb + tr16(lane, w, 0)), v1 = tr_rd(vb + tr16(lane, w, 1));
            const bf16x8 xv = PK2T(v0, v1);
            f32x4 a[2] = {{0.f, 0.f, 0.f, 0.f}, {0.f, 0.f, 0.f, 0.f}};
#pragma unroll
            for (int ks = 0; ks < 4; ++ks) {
                u32x4 t; t.x = cvt_pk_bf16(S[2 * ks][0], S[2 * ks][1]); t.y = cvt_pk_bf16(S[2 * ks][2], S[2 * ks][3]); t.z = cvt_pk_bf16(S[2 * ks + 1][0], S[2 * ks + 1][1]); t.w = cvt_pk_bf16(S[2 * ks + 1][2], S[2 * ks + 1][3]);
                const bf16x8 xs = *reinterpret_cast<bf16x8*>(&t);
                const int ch = 4 * ks + (fq >> 1);
#pragma unroll
                for (int it = 0; it < 2; ++it) { const int i = 32 * sb + 16 * it + fr;
                    const u32x2 y0 = *(LAS const u32x2*)(L + O_QT + off_b(i, ch) + 8 * (fq & 1)), y1 = *(LAS const u32x2*)(L + O_QT + off_b(i, ch + 2) + 8 * (fq & 1));
                    u32x4 ty = {y0.x, y0.y, y1.x, y1.y};
                    a[it] = __builtin_amdgcn_mfma_f32_16x16x32_bf16(xs, *reinterpret_cast<bf16x8*>(&ty), a[it], 0, 0, 0); }
            }
#pragma unroll
            for (int it = 0; it < 2; ++it) { const int il = 16 * it + fr;
                const bf16x8 ys = *(LAS const bf16x8*)(L + O_SS + sb * 2048 + il * 64 + fq * 16);
                const f32x4 aa = __builtin_amdgcn_mfma_f32_16x16x32_bf16(xv, ys, a[it], 0, 0, 0);
                u32x2 v2; v2.x = cvt_pk_bf16(aa[0], aa[1]); v2.y = cvt_pk_bf16(aa[2], aa[3]);
                *(u32x2*)(outp + (rowbase + H2_TOK(c * 64 + 32 * sb + il)) * 2048 + h * 128 + 16 * w + 4 * fq) = v2; }
            const unsigned kb = lbase + O_KS + sb * 8192;
#pragma unroll
            for (int hb = 0; hb < 2; ++hb) {
                s16x4 ka[4], kc[4]; f32x4 e4[4];
#pragma unroll
                for (int q4 = 0; q4 < 4; ++q4) { const int dt = 4 * hb + q4; ka[q4] = tr_rd(kb + tr16(lane, dt, 0)); kc[q4] = tr_rd(kb + tr16(lane, dt, 1)); e4[q4] = *(LAS const f32x4*)(L + O_EBL + sb * 512 + (16 * dt + 4 * fq) * 4); }
#pragma unroll
                for (int q4 = 0; q4 < 4; ++q4) { const int dt = 4 * hb + q4; S[dt] = __builtin_amdgcn_mfma_f32_16x16x32_bf16(PK2T(ka[q4], kc[q4]), xv, S[dt] * e4[q4], 0, 0, 0); }
            }
        }
        if (c + 1 < NIT) H2_E1();
    }
    asm volatile("s_waitcnt vmcnt(0)" ::: "memory");
    H2_BAR();
#undef H2_BAR
#undef H2_TOK
#undef H2_LOADQF
#undef H2_DMAV
#undef H2_E1
}

__device__ __forceinline__ void ret_scan_item(const Frame& F, const bf16_t* big, bf16_t* O, const float* decay, int b, int h, int sl) {
    constexpr unsigned O_Q = 0, O_K = 49152, O_V = 98304, O_SS = 122880;
    constexpr int NCH = SEQ / 32;
    LAS char* L = (LAS char*)F.lds;
    int tid = F.tid; asm volatile("" : "+v"(tid));
    const int lane = tid & 63, w = __builtin_amdgcn_readfirstlane(tid >> 6), fq = lane >> 4, fr = lane & 15, tl = fq;
    const unsigned lbase = (unsigned)(uintptr_t)L;
    const size_t rowbase = (size_t)b * SEQ;
    const int drow = 4 * w + tl, dch = fr ^ (((drow & 3) << 2) | ((drow >> 2) & 3));
    const int qcol = h * 256 + 8 * dch, kcol = 2048 + h * 256 + 8 * dch, vcol = 4096 + h * 512 + sl * 128 + 8 * dch;
    const int ocol = h * 512 + sl * 128 + 16 * w + 4 * fq;
#define RT_BAR() do { asm volatile("s_waitcnt lgkmcnt(0)" ::: "memory"); __builtin_amdgcn_s_barrier(); asm volatile("" ::: "memory"); } while (0)
#pragma unroll 1
    for (int dir = 0; dir < 2; ++dir) {
        const float lg2 = -log1pf(expf(-decay[dir * 8 + h])) * 1.4426950408889634f;
        const float g32 = exp2f(lg2 * 32.f), ig32 = exp2f(-lg2 * 32.f);
        float sc = 1.f, isc = ig32;
        float gq[2], kdec[8], wdec[4];
        gq[0] = exp2f(lg2 * (float)(fr + 1)); gq[1] = exp2f(lg2 * (float)(fr + 17));
#pragma unroll
        for (int k = 0; k < 8; ++k) kdec[k] = exp2f(lg2 * (float)(31 - (8 * fq + 4 * (k >> 2) + (k & 3))));
        const int jt = w >> 1, it1 = w & 1, ig = 16 * it1 + fr, jg = 16 * jt + 4 * fq;
#pragma unroll
        for (int r = 0; r < 4; ++r) wdec[r] = (jg + r <= ig) ? exp2f(lg2 * (float)(ig - jg - r)) : 0.f;
        f32x4 S[16];
#pragma unroll
        for (int i = 0; i < 16; ++i) S[i] = (f32x4){0.f, 0.f, 0.f, 0.f};
#define RT_TOK(p) (dir ? (SEQ - 1 - (p)) : (p))
#define RT_DMA(c, buf) do { const bf16_t* src_ = big + (rowbase + RT_TOK((c) * 32 + drow)) * 12288; \
        __builtin_amdgcn_global_load_lds((const unsigned*)(src_ + qcol), (LAS unsigned*)(L + O_Q + (buf) * 16384 + w * 1024), 16, 0, 0); \
        __builtin_amdgcn_global_load_lds((const unsigned*)(src_ + qcol + 128), (LAS unsigned*)(L + O_Q + (buf) * 16384 + 8192 + w * 1024), 16, 0, 0); \
        __builtin_amdgcn_global_load_lds((const unsigned*)(src_ + kcol), (LAS unsigned*)(L + O_K + (buf) * 16384 + w * 1024), 16, 0, 0); \
        __builtin_amdgcn_global_load_lds((const unsigned*)(src_ + kcol + 128), (LAS unsigned*)(L + O_K + (buf) * 16384 + 8192 + w * 1024), 16, 0, 0); \
        __builtin_amdgcn_global_load_lds((const unsigned*)(src_ + vcol), (LAS unsigned*)(L + O_V + (buf) * 8192 + w * 1024), 16, 0, 0); } while (0)
        RT_DMA(0, 0); RT_DMA(1, 1); asm volatile("s_waitcnt vmcnt(5)" ::: "memory");
        int buf = 0;
        for (int c = 0; c < NCH; ++c) {
            const int sb = c & 1;
            if (c + 1 < NCH) asm volatile("s_waitcnt vmcnt(7)" ::: "memory");
            else asm volatile("s_waitcnt vmcnt(0)" ::: "memory");
            RT_BAR();
            { const int nb = buf == 0 ? 2 : buf - 1;
              if (c + 2 < NCH) RT_DMA(c + 2, nb); }
            if (w < 4 && w != 2) {
                f32x4 a = {0.f, 0.f, 0.f, 0.f};
#pragma unroll
                for (int sub = 0; sub < 2; ++sub)
#pragma unroll
                    for (int s4 = 0; s4 < 4; ++s4) { const bf16x8 xk = *(LAS const bf16x8*)(L + O_K + buf * 16384 + sub * 8192 + rr16(lane, jt, s4)), yq = *(LAS const bf16x8*)(L + O_Q + buf * 16384 + sub * 8192 + rr16(lane, it1, s4));
                        a = __builtin_amdgcn_mfma_f32_16x16x32_bf16(xk, yq, a, 0, 0, 0); }
                u32x2 v2; v2.x = cvt_pk_bf16(a[0] * wdec[0], a[1] * wdec[1]); v2.y = cvt_pk_bf16(a[2] * wdec[2], a[3] * wdec[3]);
                *(LAS u32x2*)(L + O_SS + sb * 2048 + ig * 64 + jg * 2) = v2;
            }
            if (w == 2) { *(LAS u32x2*)(L + O_SS + sb * 2048 + (0 + fr) * 64 + (16 + 4 * fq) * 2) = (u32x2){0u, 0u}; }
            RT_BAR();
            {
                const unsigned vb = lbase + O_V + buf * 8192;
                const s16x4 v0 = tr_rd(vb + tr16(lane, w, 0)), v1 = tr_rd(vb + tr16(lane, w, 1));
                const bf16x8 xv = PK2T(v0, v1);
                f32x4 a[2] = {{0.f, 0.f, 0.f, 0.f}, {0.f, 0.f, 0.f, 0.f}};
                {
                    u32x2 yq[2][2][2][2];
#define RT_QRD(kp, slot) do { _Pragma("unroll") for (int k2 = 0; k2 < 2; ++k2) { const int ks_ = 2 * (kp) + k2; const unsigned qb_ = O_Q + buf * 16384 + (ks_ >> 2) * 8192; const int ch_ = 4 * (ks_ & 3) + (fq >> 1); \
                        _Pragma("unroll") for (int it = 0; it < 2; ++it) { const int i_ = 16 * it + fr; \
                            yq[slot][k2][it][0] = *(LAS const u32x2*)(L + qb_ + off_b(i_, ch_) + 8 * (fq & 1)); yq[slot][k2][it][1] = *(LAS const u32x2*)(L + qb_ + off_b(i_, ch_ + 2) + 8 * (fq & 1)); } } } while (0)
                    RT_QRD(0, 0);
#pragma unroll
                    for (int kp = 0; kp < 4; ++kp) {
                        __builtin_amdgcn_sched_barrier(0);
                        if (kp < 3) { if (kp & 1) RT_QRD(kp + 1, 0); else RT_QRD(kp + 1, 1); }
                        __builtin_amdgcn_sched_barrier(0);
#pragma unroll
                        for (int k2 = 0; k2 < 2; ++k2) { const int ks = 2 * kp + k2;
                            u32x4 t; t.x = cvt_pk_bf16(S[2 * ks][0], S[2 * ks][1]); t.y = cvt_pk_bf16(S[2 * ks][2], S[2 * ks][3]); t.z = cvt_pk_bf16(S[2 * ks + 1][0], S[2 * ks + 1][1]); t.w = cvt_pk_bf16(S[2 * ks + 1][2], S[2 * ks + 1][3]);
                            const bf16x8 xs = *reinterpret_cast<bf16x8*>(&t);
#pragma unroll
                            for (int it = 0; it < 2; ++it) { u32x4 ty = {yq[kp & 1][k2][it][0].x, yq[kp & 1][k2][it][0].y, yq[kp & 1][k2][it][1].x, yq[kp & 1][k2][it][1].y};
                                a[it] = __builtin_amdgcn_mfma_f32_16x16x32_bf16(xs, *reinterpret_cast<bf16x8*>(&ty), a[it], 0, 0, 0); } }
                    }
#undef RT_QRD
                }
                __builtin_amdgcn_sched_barrier(0);
#pragma unroll
                for (int it = 0; it < 2; ++it) { const int i = 16 * it + fr;
                    f32x4 aa = a[it] * (gq[it] * sc);
                    const bf16x8 ys = *(LAS const bf16x8*)(L + O_SS + sb * 2048 + i * 64 + fq * 16);
                    aa = __builtin_amdgcn_mfma_f32_16x16x32_bf16(xv, ys, aa, 0, 0, 0);
                    bf16_t* op = O + (rowbase + RT_TOK(c * 32 + i)) * 4096 + ocol;
                    if (dir) { const u32x2 pv = *(const u32x2*)op; aa[0] += bf_lo(pv.x); aa[1] += bf_hi(pv.x); aa[2] += bf_lo(pv.y); aa[3] += bf_hi(pv.y); }
                    u32x2 v2; v2.x = cvt_pk_bf16(aa[0], aa[1]); v2.y = cvt_pk_bf16(aa[2], aa[3]);
                    *(u32x2*)op = v2;
                }
                u32x4 yv;
                { float f0[8];
#pragma unroll
                  for (int k = 0; k < 4; ++k) { f0[k] = __uint_as_float(((unsigned)(unsigned short)v0[k]) << 16) * (kdec[k] * isc); f0[4 + k] = __uint_as_float(((unsigned)(unsigned short)v1[k]) << 16) * (kdec[4 + k] * isc); }
                  yv.x = cvt_pk_bf16(f0[0], f0[1]); yv.y = cvt_pk_bf16(f0[2], f0[3]); yv.z = cvt_pk_bf16(f0[4], f0[5]); yv.w = cvt_pk_bf16(f0[6], f0[7]); }
                const bf16x8 yvb = *reinterpret_cast<bf16x8*>(&yv);
                {
                    s16x4 ka[2][4], kc[2][4];
#define RT_KRD(bt, slot) do { _Pragma("unroll") for (int q4 = 0; q4 < 4; ++q4) { const int dt_ = 4 * (bt) + q4; const unsigned kb_ = lbase + O_K + buf * 16384 + (dt_ >> 3) * 8192; \
                        ka[slot][q4] = tr_rd(kb_ + tr16(lane, dt_ & 7, 0)); kc[slot][q4] = tr_rd(kb_ + tr16(lane, dt_ & 7, 1)); } } while (0)
                    RT_KRD(0, 0);
#pragma unroll
                    for (int bt = 0; bt < 4; ++bt) {
                        __builtin_amdgcn_sched_barrier(0);
                        if (bt < 3) { if (bt & 1) RT_KRD(bt + 1, 0); else RT_KRD(bt + 1, 1); }
                        __builtin_amdgcn_sched_barrier(0);
#pragma unroll
                        for (int q4 = 0; q4 < 4; ++q4) { const int dt = 4 * bt + q4; S[dt] = __builtin_amdgcn_mfma_f32_16x16x32_bf16(PK2T(ka[bt & 1][q4], kc[bt & 1][q4]), yvb, S[dt], 0, 0, 0); }
                    }
#undef RT_KRD
                }
            }
            buf = (buf == 2) ? 0 : buf + 1; sc *= g32; isc *= ig32;
        }
        asm volatile("s_waitcnt vmcnt(0)" ::: "memory");
        RT_BAR();
    }
#undef RT_TOK
#undef RT_DMA
#undef RT_BAR
}

#define MIX_END_BAR() do { if (g == NGROUP - 1) GRID_BAR(); else { __syncthreads(); F = make_frame(lds); nth = (long)F.G * NTHREADS; gtid0 = (long)F.bid * NTHREADS + F.tid; } } while (0)
#define GRID_BAR() do { for (int rb_ = 0; rb_ < REP_BAR; ++rb_) xcd_barrier(bar); F = make_frame(lds); nth = (long)F.G * NTHREADS; gtid0 = (long)F.bid * NTHREADS + F.tid; } while (0)

#define WL ((bf16_t*)(PWS + WS_WL))
#define Hb ((bf16_t*)(PWS + WS_H))
#define QM ((bf16_t*)(PWS + WS_QM))
#define OM ((bf16_t*)(PWS + WS_OM))
#define OB ((bf16_t*)(PWS + WS_OB))
#define BIG ((bf16_t*)(PWS + WS_BIG))
#define MN ((bf16_t*)(PWS + WS_MN))
#define MEMKV ((bf16_t*)(PWS + WS_MEMKV))
#define tab_rc ((const float*)(PWS + WS_TAB + TAB_RC))
#define tab_rs ((const float*)(PWS + WS_TAB + TAB_RS))
#define tab_mc ((const float*)(PWS + WS_TAB + TAB_MC))
#define tab_ms ((const float*)(PWS + WS_TAB + TAB_MS))
#define XBg ((bf16_t*)(PWS + WS_XB) + (size_t)g * T * DM)
#define SSQg ((float*)(PWS + WS_SSQ) + (size_t)g * T * 8)
#define EPITAB ((LAS float*)(F.lds + EPI_TAB_OFF))
template <int L>
__device__ __forceinline__ void layer_body(LAS unsigned char* lds, const XcdBarrier& bar) {
    { Frame F = make_frame(lds);
    long nth = (long)F.G * NTHREADS, gtid0 = (long)F.bid * NTHREADS + F.tid;

    convert_mat(F, PIN(I_MEM_WQ) + (size_t)L * 2048 * 512, 2048, 512, WL + W_MEMQ, PIN(I_NMEM) + L * DM);
    convert_mat(F, PIN(I_MEM_WKV) + (size_t)L * 2048 * 1024, 2048, 1024, WL + W_MEMKV, PIN(I_NMEMTOK) + L * DM);
    convert_mat(F, PIN(I_MEM_WOUT) + (size_t)L * 512 * 2048, 512, 2048, WL + W_MEMOUT);
    convert_mat(F, PIN(I_MLP_W1) + (size_t)L * 2048 * 8192, 2048, 8192, WL + W_1, PIN(I_NMLP) + L * DM);
    convert_mat(F, PIN(I_MLP_W2) + (size_t)L * 8192 * 2048, 8192, 2048, WL + W_2);
    if constexpr (L == 0) { convert_mat(F, PIN(I_RET_WIN), 2048, 12288, WL + W_IN, PIN(I_NMIX) + L * DM); convert_mat(F, PIN(I_RET_WOUT), 4096, 2048, WL + W_OUT); }
    if constexpr (L == 1) { convert_mat(F, PIN(I_HG_WIN), 2048, 10240, WL + W_IN, PIN(I_NMIX) + L * DM); convert_mat(F, PIN(I_HG_WOUT), 2048, 2048, WL + W_OUT); }
    if constexpr (L == 2) { convert_mat(F, PIN(I_MLA_WIN), 2048, 1088, WL + W_IN, PIN(I_NMIX) + L * DM); convert_mat(F, PIN(I_MLA_WOUT), 2048, 2048, WL + W_OUT);
        convert_mat(F, PIN(I_MLA_WQB), 512, 3072, WL + W_QB, PIN(I_MLA_QNORM)); convert_mat(F, PIN(I_MLA_WKVB), 512, 4096, WL + W_KVB, PIN(I_MLA_KVNORM));
        for (long i = gtid0; i < (long)(1280 - 1088) * 2048 / 8; i += nth) ((u32x4*)(WL + W_IN + (size_t)1088 * 2048))[i] = (u32x4){0u, 0u, 0u, 0u}; }
    if constexpr (L == 3) { convert_mat(F, PIN(I_GQA_WIN), 2048, 3072, WL + W_IN, PIN(I_NMIX) + L * DM); convert_mat(F, PIN(I_GQA_WOUT), 2048, 2048, WL + W_OUT); }
    if constexpr (L == 0) { xcopy_rows(F, PIN(I_XP), (bf16_t*)(PWS + WS_XB), (float*)(PWS + WS_SSQ), T); xcopy_rows(F, PIN(I_XS), (bf16_t*)(PWS + WS_XB) + (size_t)T * DM, (float*)(PWS + WS_SSQ) + (size_t)T * 8, 2 * T); }
    if constexpr (L == 0) {
        norm_rows(F, PIN(I_MP), nullptr, MN, 8 * MEMT);
        norm_rows(F, PIN(I_MS), nullptr, MN + (size_t)8 * MEMT * DM, 16 * MEMT); }
    GRID_BAR();
    if constexpr (L == 2) {
        pg8::Gemm gm{(bf16_t*)(PWS + WS_XB), WL + W_IN, 3 * T, 1280, 2048}; pg8::StaticOrder S; S.init(3 * T, 1280, F.G, F.bid, WGM_IN);
        pg8::EpiBf16<0, true, -1, true> E{(bf16_t*)(PWS + WS_BIG + MLA_C), 1280, (float*)(PWS + WS_SSQ), (float*)(PWS + WS_BIG + MLA_CQ), (LAS float*)(F.lds + EPI_TAB_OFF)};
        pg8::gemm_phase(F.lds, gm, S, E);
        GRID_BAR();
    }
    }

#pragma unroll 1
    for (int g = 0; g < NGROUP; ++g) {
        Frame F = make_frame(lds);
        long nth = (long)F.G * NTHREADS, gtid0 = (long)F.bid * NTHREADS + F.tid;
#define xo (POUT + (size_t)g * T * DM)
#define xin0 ((g == 0) ? PIN(I_XP) : PIN(I_XS) + (size_t)(g - 1) * T * DM)
#define xcur ((L == 0) ? xin0 : (const float*)xo)

        if constexpr (L == 0) {
            { pg8::Gemm gm{XBg, WL + W_IN, T, 12288, 2048}; pg8::StaticOrder S; S.init(T, 12288, F.G, F.bid, WGM_IN); pg8::EpiRetIn E{BIG, 12288, SSQg, tab_rc, tab_rs}; for (int rep = 0; rep < REP_GEMMBF; ++rep) pg8::gemm_phase(F.lds, gm, S, E); }
            GRID_BAR();
            for (int rep = 0; rep < REP_RET; ++rep) for (int u = (F.bid % 8) * (F.G / 8) + F.bid / 8  ; u < GSEQ * 8 * 4; u += F.G) { const int sl = u & 3, hh = (u >> 2) & 7, bb = u >> 5; ret_scan_item(F, BIG, OB, PIN(I_RET_DECAY), bb, hh, sl); }
            GRID_BAR();
            combine_rows<32>(F, OB, 4096, nullptr, BIG + 8192, 12288, PIN(I_RET_ONORM), OB, 4096, 8, (long)T * 8);
            GRID_BAR();
            { pg8::Gemm gm{OB, WL + W_OUT, T, 2048, 4096}; pg8::StaticOrder S; S.init(T, 2048, F.G, F.bid, WGM_RES); pg8::EpiResidX<false> E{XBg, SSQg, EPITAB, nullptr}; pg8::gemm_phase(F.lds, gm, S, E); }
            MIX_END_BAR();
        }
        if constexpr (L == 1) {
            { pg8::Gemm gm{XBg, WL + W_IN, T, 10240, 2048}; pg8::StaticOrder S; S.init(T, 10240, F.G, F.bid, WGM_IN); pg8::EpiBf16<0, true> E{BIG, 10240, SSQg}; for (int rep = 0; rep < REP_GEMMBF; ++rep) pg8::gemm_phase(F.lds, gm, S, E); }
            GRID_BAR();
            for (int rep = 0; rep < REP_HG; ++rep) for (int u = (F.bid % 8) * (F.G / 8) + F.bid / 8  ; u < GSEQ * 16 * 2; u += F.G) { const int dir = u & 1, h = (u >> 1) & 15, b = u >> 5;
                hg_scan2_item(F, BIG, PIN(I_HG_LB), OB + (size_t)dir * T * 2048, b, h, dir); }
            GRID_BAR();
            combine_rows<8>(F, OB, 2048, OB + (size_t)T * 2048, BIG + 8192, 10240, PIN(I_HG_ONORM), Hb, 2048, 16, (long)T * 16);
            GRID_BAR();
            { pg8::Gemm gm{Hb, WL + W_OUT, T, 2048, 2048}; pg8::StaticOrder S; S.init(T, 2048, F.G, F.bid, WGM_RES); pg8::EpiResidX<false> E{XBg, SSQg, EPITAB, nullptr}; pg8::gemm_phase(F.lds, gm, S, E); }
            MIX_END_BAR();
        }
        if constexpr (L == 2) {
#define Cb ((bf16_t*)(PWS + WS_BIG + MLA_C) + (size_t)g * T * 1280)
#define SS2g ((float*)(PWS + WS_BIG + MLA_CQ) + (size_t)g * T * 8)
#define Qb ((bf16_t*)(PWS + WS_BIG + MLA_Q))
#define KV ((bf16_t*)(PWS + WS_BIG + MLA_KV))
#define KK ((bf16_t*)(PWS + WS_H))
            { pg8::Gemm gm{Cb, WL + W_QB, T, 3072, 512, 1280}; pg8::StaticOrder S; S.init(T, 3072, F.G, F.bid, WGM_IN); pg8::EpiBf16<0, true, 0> E{Qb, 3072, SS2g}; for (int rep = 0; rep < REP_GEMMBF; ++rep) pg8::gemm_phase(F.lds, gm, S, E); }
            { pg8::Gemm gm{Cb + 512, WL + W_KVB, T, 4096, 512, 1280}; pg8::StaticOrder S; S.init(T, 4096, F.G, F.bid); pg8::EpiBf16<0, true, 2> E{KV, 4096, SS2g}; for (int rep = 0; rep < REP_GEMMBF; ++rep) pg8::gemm_phase(F.lds, gm, S, E); }
            GRID_BAR();
            { bf16_t* qb_ = Qb; bf16_t* kk_ = KK; const bf16_t* cb = Cb; const bf16_t* kv_ = KV; const float* gnb = PIN(I_MLA_QKNORM); const float* tmc = tab_mc; const float* tms = tab_ms;
              post_loop<16, true, 4>(gtid0, nth, (long)T * 16 * 16, 1.f / 192.f, [=](long gt) { const long hv = gt >> 4; const int j = (int)(gt & 15); const long t = hv >> 4; const int hh = 16 + (int)(hv & 15);
                const int pos = (int)(t & (SEQ - 1)); const bool isk = hh >= 16; const int h = hh & 15; const bool act = j < 12, rp = j >= 8;
                const int e1 = rp ? 128 + 8 * (j - 8) : 16 * j, e2 = rp ? e1 + 32 : e1 + 8;
                const bf16_t *s1, *s2; bf16_t *d1, *d2;
                if (!isk) { bf16_t* p = qb_ + t * 3072 + h * 192; s1 = p + e1; s2 = p + e2; d1 = p + e1; d2 = p + e2; }
                else { bf16_t* p = kk_ + t * 3072 + h * 192; d1 = p + e1; d2 = p + e2;
                       if (rp) { s1 = cb + t * 1280 + 1024 + (e1 - 128); s2 = s1 + 32; } else { s1 = kv_ + t * 4096 + h * 256 + e1; s2 = s1 + 8; } }
                const float* gn = gnb + (isk ? 192 : 0); const int ti = rp ? 8 * (j - 8) : 0;
                return PItem{s1, s2, d1, d2, gn + e1, gn + e2, tmc + pos * 32 + ti, tms + pos * 32 + ti, 1.f, rp, act}; }); }
            GRID_BAR();
            for (int rep = 0; rep < REP_ATTN; ++rep) attn_phase<192, 0, 3>(F, Qb, 3072, 192, KK, 3072, 192, KV + 128, 4096, 256, OB, 2048, 128, GSEQ, 16, 1, 1, SEQ, SEQ, 0.07216878364870322f * 1.4426950408889634f, nullptr, PIN(I_MLA_QKNORM), tab_mc, tab_ms);
            GRID_BAR();
            { pg8::Gemm gm{OB, WL + W_OUT, T, 2048, 2048}; pg8::StaticOrder S; S.init(T, 2048, F.G, F.bid, WGM_RES); pg8::EpiResidX<false> E{XBg, SSQg, EPITAB, nullptr}; pg8::gemm_phase(F.lds, gm, S, E); }
            MIX_END_BAR();
        }
        if constexpr (L == 3) { if (g == NGROUP - 1) {
#define XBa ((bf16_t*)(PWS + WS_XB))
#define SSQa ((float*)(PWS + WS_SSQ))
#define OBa ((bf16_t*)(PWS + WS_H))
            { pg8::Gemm gm{XBa, WL + W_IN, 3 * T, 3072, 2048}; pg8::StaticOrder S; S.init(3 * T, 3072, F.G, F.bid, WGM_IN); pg8::EpiBf16<0, true> E{BIG, 3072, SSQa}; for (int rep = 0; rep < REP_GEMMBF; ++rep) pg8::gemm_phase(F.lds, gm, S, E); }
            GRID_BAR();
            { bf16_t* bg = BIG; const float* gnb = PIN(I_GQA_QKNORM); const float* tmc = tab_mc; const float* tms = tab_ms;
              post_loop<8, true, 4>(gtid0, nth, (long)3 * T * 4 * 8, 1.f / 128.f, [=](long gt) { const long hv = gt >> 3; const int j = (int)(gt & 7); const long t = hv >> 2; const int hh = 16 + (int)(hv & 3);
                const int tp = (int)(t & (SEQ - 1)); const int seg = j >> 2; const int pos = seg ? (tp & 63) : (tp >> 6);
                const int e1 = seg * 64 + 8 * (j & 3), e2 = e1 + 32; bf16_t* p = bg + t * 3072 + hh * 128; const float* gn = gnb + (hh >= 16 ? 128 : 0);
                return PItem{p + e1, p + e2, p + e1, p + e2, gn + e1, gn + e2, tmc + pos * 32 + 8 * (j & 3), tms + pos * 32 + 8 * (j & 3), 1.f, true, true}; }); }
            GRID_BAR();
            for (int rep = 0; rep < REP_ATTN; ++rep) attn_phase<128, 0, 2>(F, BIG, 3072, 128, BIG + 2048, 3072, 128, BIG + 2560, 3072, 128, OBa, 2048, 128, 3 * GSEQ, 16, 4, 1, SEQ, SEQ, 0.08838834764831845f * 1.4426950408889634f, nullptr, PIN(I_GQA_QKNORM), tab_mc, tab_ms);
            GRID_BAR();
            { pg8::Gemm gm{OBa, WL + W_OUT, 3 * T, 2048, 2048}; pg8::StaticOrder S; S.init(3 * T, 2048, F.G, F.bid, WGM_RES); pg8::EpiResidX<false> E{XBa, SSQa, EPITAB, nullptr}; pg8::gemm_phase(F.lds, gm, S, E); }
            MIX_END_BAR();
        } }

    }
    {
        Frame F = make_frame(lds);
        long nth = (long)F.G * NTHREADS, gtid0 = (long)F.bid * NTHREADS + F.tid;
#define XBall ((bf16_t*)(PWS + WS_XB))
#define SSQall ((float*)(PWS + WS_SSQ))
#define QMall ((bf16_t*)(PWS + WS_H))
#define OMall ((bf16_t*)(PWS + WS_H + 48 * MiB))
        { pg8::Gemm gm{XBall, WL + W_MEMQ, 3 * T, 512, 2048}; pg8::StaticOrder S; S.init(3 * T, 512, F.G, F.bid); pg8::EpiBf16<0, true> E{QMall, 512, SSQall}; for (int rep = 0; rep < REP_GEMMBF; ++rep) pg8::gemm_phase(F.lds, gm, S, E); }
        { pg8::Gemm gm{MN, WL + W_MEMKV, MROWS, 1024, 2048}; pg8::StaticOrder S; S.init(MROWS, 1024, F.G, (F.bid + F.G / 2) % F.G);
          pg8::EpiBf16<0> E{MEMKV, 1024, nullptr}; for (int rep = 0; rep < REP_GEMMBF; ++rep) pg8::gemm_phase(F.lds, gm, S, E); }
        GRID_BAR();
        { const float* gk = PIN(I_MEM_QKNORM) + L * 256 + 128; bf16_t* mkv = MEMKV;
          post_loop<8, true, 4>(gtid0, nth, (long)MROWS * 4 * 8, 1.f / 128.f, [=](long gt) { const long hv = gt >> 3; const int j = (int)(gt & 7); const long row = hv >> 2; const int h = (int)(hv & 3);
              const int e1 = (j >> 2) * 64 + 8 * (j & 3), e2 = e1 + 32; bf16_t* p = mkv + row * 1024 + h * 128;
              return PItem{p + e1, p + e2, p + e1, p + e2, gk + e1, gk + e2, nullptr, nullptr, 1.f, false, true}; }); }
        GRID_BAR();
        for (int rep = 0; rep < REP_ATTN; ++rep) attn_phase<128, 0, 1>(F, QMall, 512, 128, MEMKV, 1024, 128, MEMKV + 512, 1024, 128, OMall, 512, 128, NBATCH, 4, 1, 1, SEQ, MEMT,
                           0.08838834764831845f * 1.4426950408889634f, nullptr, PIN(I_MEM_QKNORM) + L * 256, nullptr, nullptr);
        GRID_BAR();
        { pg8::Gemm gm{OMall, WL + W_MEMOUT, 3 * T, 2048, 512}; pg8::StaticOrder S; S.init(3 * T, 2048, F.G, F.bid, WGM_RES); pg8::EpiResidX<false> E{XBall, SSQall, EPITAB, nullptr}; pg8::gemm_phase(F.lds, gm, S, E); }
        GRID_BAR();
    }
#pragma unroll 1
    for (int g = 0; g < MLP_NG; ++g) {
        Frame F = make_frame(lds);
        long nth = (long)F.G * NTHREADS, gtid0 = (long)F.bid * NTHREADS + F.tid; (void)nth; (void)gtid0;
#define XBm ((bf16_t*)(PWS + WS_XB) + (size_t)g * MLP_T * DM)
#define SSQm ((float*)(PWS + WS_SSQ) + (size_t)g * MLP_T * 8)
#define HIDm (BIG + (size_t)(g & 1) * MLP_T * 8192)
        { pg8::Gemm gm{XBm, WL + W_1, MLP_T, 8192, 2048}; pg8::StaticOrder S; S.init(MLP_T, 8192, F.G, F.bid, WGM_MLP1); pg8::EpiBf16<1, true> E{HIDm, 8192, SSQm}; for (int rep = 0; rep < REP_GEMMBF; ++rep) pg8::gemm_phase(F.lds, gm, S, E); }
        GRID_BAR();
        { pg8::Gemm gm{HIDm, WL + W_2, MLP_T, 2048, 8192}; pg8::StaticOrder S; S.init(MLP_T, 2048, F.G, F.bid, WGM_RES); pg8::EpiResidX<L == 3> E{XBm, SSQm, EPITAB, POUT + (size_t)g * MLP_T * DM}; pg8::gemm_phase(F.lds, gm, S, E); }
        if (g == MLP_NG - 1) GRID_BAR();
        else { __syncthreads(); F = make_frame(lds); nth = (long)F.G * NTHREADS; gtid0 = (long)F.bid * NTHREADS + F.tid; }
    }
}

__global__ void __launch_bounds__(NTHREADS, 2) fwd(Params P) {
    extern __shared__ __attribute__((aligned(16))) unsigned char lds_raw[];
    LAS unsigned char* lds = (LAS unsigned char*)lds_raw;
    volatile LAS unsigned* MISC = (volatile LAS unsigned*)(lds + MISC_OFF);
    if (threadIdx.x < 16) MISC[threadIdx.x] = 0u;
    __syncthreads();
    XcdBarrier bar = xcd_barrier_post((unsigned*)(PWS + WS_CTL), MISC + 8);

    { unsigned char* ws = PWS; float* rc = (float*)(ws + WS_TAB + TAB_RC); float* rs = (float*)(ws + WS_TAB + TAB_RS); float* mc = (float*)(ws + WS_TAB + TAB_MC); float* ms = (float*)(ws + WS_TAB + TAB_MS);
      const long nth = (long)gridDim.x * NTHREADS;
      for (long i = (long)blockIdx.x * NTHREADS + threadIdx.x; i < (long)SEQ * 128; i += nth) { const int pos = (int)(i >> 7), k = (int)(i & 127);
          const float fr = powf(10000.f, -(float)k / 128.f); const float ang = (float)pos * fr; rc[i] = cosf(ang); rs[i] = sinf(ang); }
      for (long i = (long)blockIdx.x * NTHREADS + threadIdx.x; i < (long)SEQ * 32; i += nth) { const int pos = (int)(i >> 5), k = (int)(i & 31);
          const float fr = powf(10000.f, -(float)k / 32.f); const float ang = (float)pos * fr; mc[i] = cosf(ang); ms[i] = sinf(ang); } }

#ifndef ONLY_L
    layer_body<0>(lds, bar);
    layer_body<1>(lds, bar);
    layer_body<2>(lds, bar);
    layer_body<3>(lds, bar);
#else
    layer_body<ONLY_L>(lds, bar);
#endif
}

extern "C" void kernel_launch(void* const* d_in, const int* in_sizes, int n_in, void* d_out, int out_size, void* d_ws, size_t ws_size, hipStream_t stream) {
    static int grid = 0;
    if (grid == 0) {
        if (n_in != 32 || out_size != NBATCH * SEQ * DM || ws_size < WS_END) { fprintf(stderr, "kernel_launch: unexpected shapes: n_in %d out %d ws %zu (need %zu)\n", n_in, out_size, ws_size, (size_t)WS_END); grid = -1; return; }
        int dev = 0, cus = 0;
        if (hipGetDevice(&dev) != hipSuccess || hipDeviceGetAttribute(&cus, hipDeviceAttributeMultiprocessorCount, dev) != hipSuccess) { grid = -1; return; }
        if (hipFuncSetAttribute((const void*)fwd, hipFuncAttributeMaxDynamicSharedMemorySize, LDS_BYTES) != hipSuccess) { fprintf(stderr, "kernel_launch: hipFuncSetAttribute failed\n"); grid = -1; return; }
        int per_cu = 0;
        if (hipOccupancyMaxActiveBlocksPerMultiprocessor(&per_cu, (const void*)fwd, NTHREADS, LDS_BYTES) != hipSuccess || per_cu < 1) fprintf(stderr, "kernel_launch: occupancy query says %d\n", per_cu);
        (void)hipGetLastError();
        grid = cus;
    }
    if (grid < 0) return;
    (void)hipMemsetAsync((char*)d_ws + WS_CTL, 0, XCD_BAR_WORDS * sizeof(unsigned), stream);
    Params p{};
    for (int i = 0; i < 32; ++i) p.in[i] = (const float*)d_in[i];
    p.out = (float*)d_out; p.ws = (unsigned char*)d_ws;
    hipLaunchKernelGGL(fwd, dim3(grid), dim3(NTHREADS), LDS_BYTES, stream, p);
    const hipError_t le = hipPeekAtLastError();
    if (le != hipSuccess) fprintf(stderr, "kernel_launch: launch failed: %s\n", hipGetErrorName(le));
}
```

```cpp
#include <hip/hip_runtime.h>
#include <cstdio>
#include <cstdint>

#define LAS __attribute__((address_space(3)))
#ifndef REP_RET
#define REP_RET 1
#endif
#ifndef REP_HG
#define REP_HG 1
#endif
#ifndef REP_ATTN
#define REP_ATTN 1
#endif
#ifndef REP_GEMMBF
#define REP_GEMMBF 1
#endif
#ifndef REP_NORM
#define REP_NORM 1
#endif
#ifndef WGM_RES
#define WGM_RES 4
#endif
#ifndef WGM_MLP1
#define WGM_MLP1 4
#endif
#ifndef WGM_IN
#define WGM_IN 4
#endif
#ifndef REP_BAR
#define REP_BAR 1
#endif
#ifndef REP_CONV
#define REP_CONV 1
#endif
typedef unsigned short bf16_t;
typedef short bf16x8 __attribute__((ext_vector_type(8)));
typedef short s16x4 __attribute__((ext_vector_type(4)));
typedef float f32x4 __attribute__((ext_vector_type(4)));
typedef float f32x16 __attribute__((ext_vector_type(16)));
typedef unsigned u32x2 __attribute__((ext_vector_type(2)));
typedef unsigned u32x4 __attribute__((ext_vector_type(4)));

constexpr int DM = 2048, SEQ = 2048, NBATCH = 24, GSEQ = 8, T = GSEQ * SEQ, NGROUP = 3, MEMT = 256, MROWS = NBATCH * MEMT;
constexpr float EPS = 1e-6f;
constexpr int NWAVES = 8, NTHREADS = 512;
#ifndef MLP_NG
#define MLP_NG 6
#endif
constexpr int MLP_T = NBATCH * SEQ / MLP_NG;

constexpr size_t MiB = 1u << 20;
constexpr size_t WS_CTL = 0, CTL_BYTES = 1 * MiB;
constexpr size_t WS_TAB = 1 * MiB;
constexpr size_t TAB_RC = 0, TAB_RS = 1 * MiB, TAB_MC = 2 * MiB, TAB_MS = 2 * MiB + 256 * 1024;
constexpr size_t WS_MN = 4 * MiB;
constexpr size_t WS_MEMKV = 28 * MiB;
constexpr size_t WS_WL = 40 * MiB;
constexpr size_t WS_H = 184 * MiB;
constexpr size_t WS_QM = 248 * MiB;
constexpr size_t WS_OM = 264 * MiB;
constexpr size_t WS_OB = 280 * MiB;
constexpr size_t WS_BIG = 408 * MiB;
constexpr size_t WS_XB = 808 * MiB;
constexpr size_t WS_SSQ = 1000 * MiB;
constexpr size_t WS_END = 1002 * MiB;
constexpr size_t W_MEMQ = 0, W_MEMKV = W_MEMQ + 512 * 2048, W_MEMOUT = W_MEMKV + 1024 * 2048, W_1 = W_MEMOUT + 2048 * 512, W_2 = W_1 + (size_t)8192 * 2048,
                 W_IN = W_2 + (size_t)2048 * 8192, W_OUT = W_IN + (size_t)12288 * 2048, W_QB = W_OUT + (size_t)2048 * 4096, W_KVB = W_QB + 3072 * 512, W_TOTAL = W_KVB + 4096 * 512;
static_assert(W_TOTAL * 2 <= 144 * MiB, "weights region");
constexpr size_t MLA_C = 0, MLA_CQ = 120 * MiB, MLA_Q = 122 * MiB, MLA_KV = 218 * MiB;

constexpr int LDS_BYTES = 147456;
constexpr int MISC_OFF = 131072;
constexpr int EPI_TAB_OFF = 132096;

typedef float f32x2_ __attribute__((ext_vector_type(2)));
typedef __bf16 bf16x2_ __attribute__((ext_vector_type(2)));
__device__ __forceinline__ unsigned cvt_pk_bf16(float lo, float hi) { const f32x2_ v = {lo, hi}; const bf16x2_ b = __builtin_convertvector(v, bf16x2_); return __builtin_bit_cast(unsigned, b); }
__device__ __forceinline__ float bf_lo(unsigned w) { return __uint_as_float(w << 16); }
__device__ __forceinline__ float bf_hi(unsigned w) { return __uint_as_float(w & 0xffff0000u); }
__device__ __forceinline__ void ld8(const bf16_t* p, float (&v)[8]) { const u32x4 w = *(const u32x4*)p; v[0] = bf_lo(w.x); v[1] = bf_hi(w.x); v[2] = bf_lo(w.y); v[3] = bf_hi(w.y); v[4] = bf_lo(w.z); v[5] = bf_hi(w.z); v[6] = bf_lo(w.w); v[7] = bf_hi(w.w); }
__device__ __forceinline__ void st8(bf16_t* p, const float (&v)[8]) { u32x4 w; w.x = cvt_pk_bf16(v[0], v[1]); w.y = cvt_pk_bf16(v[2], v[3]); w.z = cvt_pk_bf16(v[4], v[5]); w.w = cvt_pk_bf16(v[6], v[7]); *(u32x4*)p = w; }
__device__ __forceinline__ float wave_sum(float v) {
#pragma unroll
    for (int o = 1; o < 64; o <<= 1) v += __shfl_xor(v, o);
    return v;
}
__device__ __forceinline__ float sigmoidf_(float x) { return __builtin_amdgcn_rcpf(1.0f + __expf(-x)); }
#define LDS_WAIT() asm volatile("s_waitcnt lgkmcnt(0)" ::: "memory")

#define XB_TMO      128
#define XB_XCNT(j)  (256  + 64 * (j))
#define XB_XSUB(j)  (1280 + 64 * (j))
#define XB_XGEN(j)  (2304 + 64 * (j))
#define XB_TOP      3328
#define XB_TOPGEN   3392
#define XCD_BAR_WORDS 3456
#define XB_SPIN_CAP (1u << 24)

typedef __attribute__((address_space(1))) unsigned gu32_t;
__device__ __forceinline__ unsigned xb_ld(unsigned* p)              { return __hip_atomic_load((gu32_t*)p, __ATOMIC_RELAXED, __HIP_MEMORY_SCOPE_AGENT); }
__device__ __forceinline__ unsigned xb_add(unsigned* p, unsigned v) { return __hip_atomic_fetch_add((gu32_t*)p, v, __ATOMIC_RELAXED, __HIP_MEMORY_SCOPE_AGENT); }
__device__ __forceinline__ unsigned xb_xcc_id() { return (unsigned)__builtin_amdgcn_s_getreg((3 << 11) | 20) & 0xFu; }
#define XB_SPIN(cond, bar) do { unsigned _sp = 0; while (cond) { __builtin_amdgcn_s_sleep(1); \
    if ((++_sp & 255u) == 0u) { if (xb_ld(&(bar)[XB_TMO])) break; if (_sp > XB_SPIN_CAP) { (void)xb_add(&(bar)[XB_TMO], 1u); break; } } } } while (0)

struct XcdBarrier { unsigned* bar; unsigned x; volatile LAS unsigned* st; };

__device__ __forceinline__ XcdBarrier xcd_barrier_post(unsigned* bar, volatile LAS unsigned* st) {
    XcdBarrier b; b.bar = bar; b.x = xb_xcc_id(); b.st = st;
    if (threadIdx.x == 0) (void)xb_add(&bar[XB_XCNT(b.x)], 1u);
    return b;
}
__device__ __forceinline__ void xcd_barrier_complete(unsigned* bar, unsigned x, unsigned& nloc, unsigned& nx) {
    const unsigned G = gridDim.x * gridDim.y * gridDim.z;
    unsigned sum, cnt, mine, sp = 0u;
    for (;;) {
        sum = 0u; cnt = 0u; mine = 0u;
#pragma unroll
        for (unsigned j = 0; j < 16; ++j) { const unsigned c = xb_ld(&bar[XB_XCNT(j)]); sum += c; cnt += (c > 0u) ? 1u : 0u; mine = (j == x) ? c : mine; }
        if (sum == G) break;
        __builtin_amdgcn_s_sleep(1);
        if ((++sp & 255u) == 0u) { if (xb_ld(&bar[XB_TMO])) break; if (sp > XB_SPIN_CAP) { (void)xb_add(&bar[XB_TMO], 1u); break; } }
    }
    nloc = mine > 0u ? mine : 1u; nx = cnt > 0u ? cnt : 1u;
}
__device__ __forceinline__ void xcd_barrier(const XcdBarrier& b) {
    asm volatile("s_waitcnt vmcnt(0)" ::: "memory");
    __syncthreads();
    if (threadIdx.x == 0) {
        unsigned* bar = b.bar; asm volatile("" : "+s"(bar)); unsigned bx = b.x; asm volatile("" : "+s"(bx));
        __builtin_amdgcn_s_waitcnt(0);
        unsigned nloc = b.st[0], nx = b.st[1];
        if (nloc == 0u) { xcd_barrier_complete(bar, bx, nloc, nx); b.st[0] = nloc; b.st[1] = nx; }
        const unsigned old = xb_add(&bar[XB_XSUB(bx)], 1u);
        const unsigned gen = old / nloc;
        if (old + 1u == (gen + 1u) * nloc) {
            __builtin_amdgcn_fence(__ATOMIC_RELEASE, "agent");
            asm volatile("s_waitcnt vmcnt(0)" ::: "memory");
            const unsigned og = xb_add(&bar[XB_TOP], 1u);
            const unsigned tg = og / nx;
            if (og + 1u == (tg + 1u) * nx) xb_add(&bar[XB_TOPGEN], 1u);
            else XB_SPIN(xb_ld(&bar[XB_TOPGEN]) == tg, bar);
            __builtin_amdgcn_fence(__ATOMIC_ACQUIRE, "agent");
            xb_add(&bar[XB_XGEN(bx)], 1u);
            asm volatile("s_waitcnt vmcnt(0)" ::: "memory");
        } else {
            XB_SPIN(xb_ld(&bar[XB_XGEN(bx)]) == gen, bar);
            __builtin_amdgcn_fence(__ATOMIC_ACQUIRE, "agent");
            asm volatile("s_waitcnt vmcnt(0)" ::: "memory");
        }
    }
    __syncthreads();
}

namespace pg8 {
constexpr int BM = 256, BK = 64, HALF = 128, HTB = HALF * BK * 2, STAGE_BYTES = 8 * HTB, NXCD = 8, WGM = 8;
__host__ __device__ __forceinline__ int lds_byte(int r, int c) { const int st = (r >> 4) * 2 + (c >> 5), rr = r & 15, cc = c & 31, ob = rr * 64 + cc * 2; return st * 1024 + (ob ^ (((ob >> 9) & 1) << 5)); }
__host__ __device__ __forceinline__ void stage_rc(int b, int& R, int& C) { const int st = b / 1024, sb = b % 1024, swz = sb ^ (((sb >> 9) & 1) << 5); R = (st >> 1) * 16 + swz / 64; C = (st & 1) * 32 + (swz % 64) / 2; }
__host__ __device__ __forceinline__ int perm32(int rho) { const int n = rho >> 4, i = rho & 15; return 8 * (i >> 2) + 4 * n + (i & 3); }

struct Unit { int pm, pn; int wt = 0; };
struct Gemm { const bf16_t* A; const bf16_t* Bt; int M, N, K; int lda = 0; };

struct StaticOrder {
    int nM, nN, nwg, G, c, wgm;
    __host__ __device__ void init(int M, int N, int G_, int c_, int wgm_ = 4) { nM = M / BM; nN = N / BM; nwg = nM * nN; G = G_; c = c_; wgm = wgm_; }
    __host__ __device__ bool next(int i, Unit& u) const {
        const long L = (long)i * G + c; if (L >= nwg) return false;
        int wgid = (int)L; { const int q = nwg / NXCD, r = nwg % NXCD, xcd = wgid % NXCD, off = wgid / NXCD; wgid = (xcd < r ? xcd * (q + 1) : r * (q + 1) + (xcd - r) * q) + off; }
        const int nig = wgm * nN, gid = wgid / nig, fm = gid * wgm, gsz = (nM - fm) < wgm ? (nM - fm) : wgm;
        u.pm = fm + ((wgid % nig) % gsz); u.pn = (wgid % nig) / gsz; return true;
    }
    __device__ __forceinline__ void a_ready(const Unit&) const {}
    __device__ __forceinline__ void done(const Unit&) const {}
};

template <int ACT  , bool RS = false  ,
          int SO = -1  , bool SSOUT = false  > struct EpiBf16 {
    static constexpr bool PERM = true;
    bf16_t* O; int ldc; const float* SSQ; float* SS2 = nullptr; LAS float* tab = nullptr;
    __device__ __forceinline__ void operator()(const f32x4 (&acc)[2][2][4][2], const Unit& u, int wr, int wc, int fr, int fq) const {
        if (u.wt) run<true>(acc, u, wr, wc, fr, fq); else run<false>(acc, u, wr, wc, fr, fq);
    }
    template <bool WT> __device__ __forceinline__ void run(const f32x4 (&acc)[2][2][4][2], const Unit& u, int wr, int wc, int fr, int fq) const {
        const int row0 = u.pm * BM + wr * 64 + fr, col0 = u.pn * BM + wc * 32 + 8 * fq;
        float rsv[2][4];
#pragma unroll
        for (int ai = 0; ai < 2; ++ai)
#pragma unroll
            for (int m = 0; m < 4; ++m) { float rs = 1.f;
                if (RS && SO < 0) { const f32x4 p0 = *(const f32x4*)(SSQ + (size_t)(row0 + ai * HALF + m * 16) * 8), p1 = *(const f32x4*)(SSQ + (size_t)(row0 + ai * HALF + m * 16) * 8 + 4);
                    rs = rsqrtf(((p0[0] + p0[1]) + (p0[2] + p0[3]) + (p1[0] + p1[1]) + (p1[2] + p1[3])) * (1.f / DM) + EPS); }
                if (SO >= 0) { const f32x4 p0 = *(const f32x4*)(SSQ + (size_t)(row0 + ai * HALF + m * 16) * 8); rs = rsqrtf((p0[SO & 3] + p0[(SO + 1) & 3]) * (1.f / 512.f) + EPS); }
                rsv[ai][m] = rs; }
        if (RS || SO >= 0) asm volatile("" : "+v"(rsv[0][0]), "+v"(rsv[0][1]), "+v"(rsv[0][2]), "+v"(rsv[0][3]), "+v"(rsv[1][0]), "+v"(rsv[1][1]), "+v"(rsv[1][2]), "+v"(rsv[1][3]));
#pragma unroll
        for (int ai = 0; ai < 2; ++ai)
#pragma unroll
            for (int m = 0; m < 4; ++m) { bf16_t* rowp = O + (size_t)(row0 + ai * HALF + m * 16) * ldc + col0;
                const float rs = rsv[ai][m]; float ps = 0.f;
#pragma unroll
                for (int bj = 0; bj < 2; ++bj) { f32x4 v0 = acc[ai][bj][m][0] * rs, v1 = acc[ai][bj][m][1] * rs;
                    if (ACT == 1) {
#pragma unroll
                        for (int j = 0; j < 4; ++j) { const float a = fmaxf(v0[j], 0.f), b = fmaxf(v1[j], 0.f); v0[j] = a * a; v1[j] = b * b; } }
                    if (SSOUT) ps += (v0[0] * v0[0] + v0[1] * v0[1]) + (v0[2] * v0[2] + v0[3] * v0[3]) + (v1[0] * v1[0] + v1[1] * v1[1]) + (v1[2] * v1[2] + v1[3] * v1[3]);
                    u32x4 w; w.x = cvt_pk_bf16(v0[0], v0[1]); w.y = cvt_pk_bf16(v0[2], v0[3]); w.z = cvt_pk_bf16(v1[0], v1[1]); w.w = cvt_pk_bf16(v1[2], v1[3]);
                    if constexpr (WT) asm volatile("global_store_dwordx4 %0, %1, off sc1\n\ts_nop 1" :: "v"(rowp + bj * HALF), "v"(w));     else *(u32x4*)(rowp + bj * HALF) = w; }
                if (SSOUT) { ps += __shfl_xor(ps, 16); ps += __shfl_xor(ps, 32); if (fq == 0) tab[(ai * HALF + wr * 64 + m * 16 + fr) * 4 + wc] = ps; } }
        if (SSOUT) {
            asm volatile("s_waitcnt lgkmcnt(0)" ::: "memory"); __builtin_amdgcn_s_barrier(); asm volatile("" ::: "memory");
            const int t = threadIdx.x;
            if (t < 256) { const f32x4 p = *(LAS const f32x4*)(tab + t * 4); SS2[(size_t)(u.pm * BM + t) * 8 + u.pn] = (p[0] + p[1]) + (p[2] + p[3]); }
        }
    }
};
template <bool FINAL> struct EpiResidX {
    static constexpr bool PERM = true;
    bf16_t* XB; float* SSQ; LAS float* tab; float* OUT;
    __device__ __forceinline__ void operator()(const f32x4 (&acc)[2][2][4][2], const Unit& u, int wr, int wc, int fr, int fq) const {
        const int row0 = u.pm * BM + wr * 64 + fr, col0 = u.pn * BM + wc * 32 + 8 * fq;
        u32x4 xw[2][4][2];
#pragma unroll
        for (int ai = 0; ai < 2; ++ai)
#pragma unroll
            for (int m = 0; m < 4; ++m)
#pragma unroll
                for (int bj = 0; bj < 2; ++bj) xw[ai][m][bj] = *(const u32x4*)(XB + (size_t)(row0 + ai * HALF + m * 16) * DM + col0 + bj * HALF);
#pragma unroll
        for (int ai = 0; ai < 2; ++ai)
#pragma unroll
            for (int m = 0; m < 4; ++m) { const size_t ro = (size_t)(row0 + ai * HALF + m * 16) * DM + col0; float ps = 0.f;
#pragma unroll
                for (int bj = 0; bj < 2; ++bj) { const u32x4 w4 = xw[ai][m][bj];
                    const f32x4 x0 = (f32x4){bf_lo(w4.x), bf_hi(w4.x), bf_lo(w4.y), bf_hi(w4.y)} + acc[ai][bj][m][0], x1 = (f32x4){bf_lo(w4.z), bf_hi(w4.z), bf_lo(w4.w), bf_hi(w4.w)} + acc[ai][bj][m][1];
                    if (FINAL) { __builtin_nontemporal_store(x0, (f32x4*)(OUT + ro + bj * HALF)); __builtin_nontemporal_store(x1, (f32x4*)(OUT + ro + bj * HALF + 4)); }
                    else {
                        ps += (x0[0] * x0[0] + x0[1] * x0[1]) + (x0[2] * x0[2] + x0[3] * x0[3]) + (x1[0] * x1[0] + x1[1] * x1[1]) + (x1[2] * x1[2] + x1[3] * x1[3]);
                        u32x4 w; w.x = cvt_pk_bf16(x0[0], x0[1]); w.y = cvt_pk_bf16(x0[2], x0[3]); w.z = cvt_pk_bf16(x1[0], x1[1]); w.w = cvt_pk_bf16(x1[2], x1[3]);
                        *(u32x4*)(XB + ro + bj * HALF) = w; } }
                if (!FINAL) { ps += __shfl_xor(ps, 16); ps += __shfl_xor(ps, 32);
                    if (fq == 0) tab[(ai * HALF + wr * 64 + m * 16 + fr) * 4 + wc] = ps; } }
        if (!FINAL) {
            asm volatile("s_waitcnt lgkmcnt(0)" ::: "memory"); __builtin_amdgcn_s_barrier(); asm volatile("" ::: "memory");
            const int t = threadIdx.x;
            if (t < 256) { const f32x4 p = *(LAS const f32x4*)(tab + t * 4); SSQ[(size_t)(u.pm * BM + t) * 8 + u.pn] = (p[0] + p[1]) + (p[2] + p[3]); }
        }
    }
};
struct EpiRetIn {
    static constexpr bool PERM = true;
    bf16_t* O; int ldc; const float* SSQ; const float* ct; const float* st;
    __device__ __forceinline__ void operator()(const f32x4 (&acc)[2][2][4][2], const Unit& u, int wr, int wc, int fr, int fq) const {
        const int row0 = u.pm * BM + wr * 64 + fr, col0 = u.pn * BM + wc * 32 + 8 * fq; const bool rope = u.pn < 16; const float qs = u.pn < 8 ? 0.0625f : 1.f;
#pragma unroll
        for (int ai = 0; ai < 2; ++ai)
#pragma unroll
            for (int m = 0; m < 4; ++m) { const int row = row0 + ai * HALF + m * 16; bf16_t* rowp = O + (size_t)row * ldc + col0;
                const f32x4 p0 = *(const f32x4*)(SSQ + (size_t)row * 8), p1 = *(const f32x4*)(SSQ + (size_t)row * 8 + 4);
                const float rs = rsqrtf(((p0[0] + p0[1]) + (p0[2] + p0[3]) + (p1[0] + p1[1]) + (p1[2] + p1[3])) * (1.f / DM) + EPS) * qs;
                f32x4 a0 = acc[ai][0][m][0] * rs, a1 = acc[ai][0][m][1] * rs, b0 = acc[ai][1][m][0] * rs, b1 = acc[ai][1][m][1] * rs;
                if (rope) { const int pos = row & (SEQ - 1); const float* cp = ct + pos * 128 + wc * 32 + 8 * fq; const float* sp = st + pos * 128 + wc * 32 + 8 * fq;
                    const f32x4 c0 = *(const f32x4*)cp, c1 = *(const f32x4*)(cp + 4), s0 = *(const f32x4*)sp, s1 = *(const f32x4*)(sp + 4);
                    const f32x4 na0 = a0 * c0 - b0 * s0, na1 = a1 * c1 - b1 * s1, nb0 = a0 * s0 + b0 * c0, nb1 = a1 * s1 + b1 * c1; a0 = na0; a1 = na1; b0 = nb0; b1 = nb1; }
                u32x4 w; w.x = cvt_pk_bf16(a0[0], a0[1]); w.y = cvt_pk_bf16(a0[2], a0[3]); w.z = cvt_pk_bf16(a1[0], a1[1]); w.w = cvt_pk_bf16(a1[2], a1[3]); *(u32x4*)rowp = w;
                w.x = cvt_pk_bf16(b0[0], b0[1]); w.y = cvt_pk_bf16(b0[2], b0[3]); w.z = cvt_pk_bf16(b1[0], b1[1]); w.w = cvt_pk_bf16(b1[2], b1[3]); *(u32x4*)(rowp + HALF) = w; }
    }
};
struct EpiResid {
    static constexpr bool PERM = false;
    const float* Xi; float* Xo; int ldc;
    __device__ __forceinline__ void operator()(const f32x4 (&acc)[2][2][4][2], const Unit& u, int wr, int wc, int fr, int fq) const {
        const int row0 = u.pm * BM + wr * 64 + fr, col0 = u.pn * BM + wc * 32 + 4 * fq;
#pragma unroll
        for (int ai = 0; ai < 2; ++ai)
#pragma unroll
            for (int m = 0; m < 4; ++m) { const size_t ro = (size_t)(row0 + ai * HALF + m * 16) * ldc + col0;
#pragma unroll
                for (int bj = 0; bj < 2; ++bj)
#pragma unroll
                    for (int n = 0; n < 2; ++n) { const f32x4 x = *(const f32x4*)(Xi + ro + bj * HALF + n * 16); *(f32x4*)(Xo + ro + bj * HALF + n * 16) = x + acc[ai][bj][m][n]; } }
    }
};

template <class Epi, class Sched>
__device__ __forceinline__ void gemm_phase(LAS unsigned char* lds, const Gemm g, const Sched& S, const Epi& E) {
    int tid = threadIdx.x; asm volatile("" : "+v"(tid));
    const int wid = __builtin_amdgcn_readfirstlane(tid >> 6), lane = tid & 63, wr = wid >> 2, wc = wid & 3, fr = lane & 15, fq = lane >> 4;
    const int K = g.K, nt = K / BK, lda = g.lda ? g.lda : K;
    unsigned voffA[2], voffB[2];
#pragma unroll
    for (int i = 0; i < 2; ++i) { int R, C; stage_rc(tid * 16 + i * 8192, R, C); const int Rb = Epi::PERM ? ((R & ~31) + perm32(R & 31)) : R;
        voffA[i] = (unsigned)(R * lda + C) * 2u; voffB[i] = (unsigned)(Rb * K + C) * 2u; }
    const size_t kstep = (size_t)(BK * 2);
    const size_t hstep = (size_t)HALF * K * 2, hstepA = (size_t)HALF * lda * 2;
    const size_t tstep = 2 * hstep, tstepA = 2 * hstepA;
    const unsigned ldsw = (unsigned)wid * 1024u;
    const int aoff = lds_byte(wr * 64 + fr, fq * 8), boff = lds_byte(wc * 32 + fr, fq * 8);
#define PG8_SA(b, h) (((b) * 2 + (h)) * HTB)
#define PG8_SB(b, h) ((4 + (b) * 2 + (h)) * HTB)
#define PG8_STAGE(bufoff, gbase, voff) do { _Pragma("unroll") for (int _i = 0; _i < 2; ++_i) \
        __builtin_amdgcn_global_load_lds((const unsigned*)((const char*)(gbase) + (voff)[_i]), (LAS unsigned*)(lds + (bufoff) + ldsw + _i * 8192), 16, 0, 0); } while (0)
#define PG8_LDA(dst, b, h) do { _Pragma("unroll") for (int m = 0; m < 4; ++m) _Pragma("unroll") for (int k = 0; k < 2; ++k) dst[m][k] = *(const LAS bf16x8*)(lds + PG8_SA(b, h) + aoff + m * 2048 + k * 1024); } while (0)
#define PG8_LDB(dst, b, h) do { _Pragma("unroll") for (int n = 0; n < 2; ++n) _Pragma("unroll") for (int k = 0; k < 2; ++k) dst[n][k] = *(const LAS bf16x8*)(lds + PG8_SB(b, h) + boff + n * 2048 + k * 1024); } while (0)
#define PG8_MMA(ai, bj, At, Bt) do { __builtin_amdgcn_s_setprio(1); _Pragma("unroll") for (int m = 0; m < 4; ++m) _Pragma("unroll") for (int n = 0; n < 2; ++n) _Pragma("unroll") for (int k = 0; k < 2; ++k) \
        acc[ai][bj][m][n] = __builtin_amdgcn_mfma_f32_16x16x32_bf16(Bt[n][k], At[m][k], acc[ai][bj][m][n], 0, 0, 0); __builtin_amdgcn_s_setprio(0); } while (0)
#define PG8_WAIT_V(n) asm volatile("s_waitcnt vmcnt(" #n ")" ::: "memory")
#define PG8_WAIT_L(n) asm volatile("s_waitcnt lgkmcnt(" #n ")" ::: "memory")
#define PG8_BAR __builtin_amdgcn_s_barrier()
#define PG8_SCHED __builtin_amdgcn_sched_barrier(0)
    Unit cur, nxt; int ui = 0;
    if (!S.next(0, cur)) return;
    f32x4 acc[2][2][4][2];
#pragma unroll
    for (int a = 0; a < 2; ++a)
#pragma unroll
        for (int b = 0; b < 2; ++b)
#pragma unroll
            for (int m = 0; m < 4; ++m)
#pragma unroll
                for (int n = 0; n < 2; ++n) acc[a][b][m][n] = (f32x4){0.f, 0.f, 0.f, 0.f};
    bf16x8 At[4][2], B0[2][2], B1[2][2];
    const char* cA = (const char*)g.A + (size_t)cur.pm * tstepA; const char* cB = (const char*)g.Bt + (size_t)cur.pn * tstep;
    S.a_ready(cur);
    PG8_STAGE(PG8_SB(0, 0), cB, voffB); PG8_STAGE(PG8_SB(0, 1), cB + hstep, voffB); PG8_STAGE(PG8_SA(0, 0), cA, voffA); PG8_STAGE(PG8_SA(0, 1), cA + hstepA, voffA);
    if (wr == 1) PG8_BAR;
    PG8_WAIT_V(2); PG8_BAR;
    PG8_STAGE(PG8_SB(1, 0), cB + kstep, voffB); PG8_STAGE(PG8_SA(1, 0), cA + kstep, voffA); PG8_STAGE(PG8_SB(1, 1), cB + hstep + kstep, voffB);
    PG8_WAIT_V(6); PG8_BAR;
    for (;;) {
        const bool has_next = S.next(ui + 1, nxt);
        const char* nA = has_next ? (const char*)g.A + (size_t)nxt.pm * tstepA : cA; const char* nB = has_next ? (const char*)g.Bt + (size_t)nxt.pn * tstep : cB;
        for (int t = 0; t < nt; t += 2) {
            const bool last = (t == nt - 2);
            const char* a1 = cA + (size_t)(t + 1) * kstep;
            const char* a2 = last ? nA : cA + (size_t)(t + 2) * kstep; const char* b2 = last ? nB : cB + (size_t)(t + 2) * kstep;
            const char* a3 = a2 + kstep; const char* b3 = b2 + kstep;
            if (last && has_next) S.a_ready(nxt);
            PG8_LDB(B0, 0, 0); PG8_LDB(B1, 0, 1); PG8_SCHED; PG8_LDA(At, 0, 0); PG8_STAGE(PG8_SA(1, 1), a1 + hstepA, voffA);
            PG8_WAIT_V(8); PG8_WAIT_L(0); PG8_BAR; PG8_MMA(0, 0, At, B0); PG8_MMA(0, 1, At, B1); PG8_BAR; PG8_SCHED;
            PG8_LDA(At, 0, 1); PG8_STAGE(PG8_SB(0, 0), b2, voffB); PG8_STAGE(PG8_SB(0, 1), b2 + hstep, voffB); PG8_STAGE(PG8_SA(0, 0), a2, voffA);
            PG8_WAIT_V(8); PG8_WAIT_L(0); PG8_BAR; PG8_MMA(1, 0, At, B0); PG8_MMA(1, 1, At, B1); PG8_BAR; PG8_SCHED;
            PG8_LDB(B0, 1, 0); PG8_LDB(B1, 1, 1); PG8_SCHED; PG8_LDA(At, 1, 0); PG8_STAGE(PG8_SA(0, 1), a2 + hstepA, voffA);
            PG8_WAIT_V(8); PG8_WAIT_L(0); PG8_BAR; PG8_MMA(0, 0, At, B0); PG8_MMA(0, 1, At, B1); PG8_BAR; PG8_SCHED;
            PG8_LDA(At, 1, 1); PG8_STAGE(PG8_SB(1, 0), b3, voffB); PG8_STAGE(PG8_SB(1, 1), b3 + hstep, voffB); PG8_STAGE(PG8_SA(1, 0), a3, voffA);
            PG8_WAIT_V(8); PG8_WAIT_L(0); PG8_BAR; PG8_MMA(1, 0, At, B0); PG8_MMA(1, 1, At, B1); PG8_BAR; PG8_SCHED;
        }
        if (wr == 0) PG8_BAR;
        cur.wt = has_next ? 0 : 1;
        E(acc, cur, wr, wc, fr, fq); S.done(cur);
        if (!has_next) break;
#pragma unroll
        for (int a = 0; a < 2; ++a)
#pragma unroll
            for (int b = 0; b < 2; ++b)
#pragma unroll
                for (int m = 0; m < 4; ++m)
#pragma unroll
                    for (int n = 0; n < 2; ++n) acc[a][b][m][n] = (f32x4){0.f, 0.f, 0.f, 0.f};
        cur = nxt; cA = nA; cB = nB; ++ui;
        if (wr == 1) PG8_BAR;
    }
    PG8_WAIT_V(0);
    PG8_BAR;
#undef PG8_SA
#undef PG8_SB
#undef PG8_STAGE
#undef PG8_LDA
#undef PG8_LDB
#undef PG8_MMA
#undef PG8_WAIT_V
#undef PG8_WAIT_L
#undef PG8_BAR
#undef PG8_SCHED
}
}

struct Params { const float* in[32]; float* out; unsigned char* ws; };
enum { I_XP = 0, I_XS, I_MP, I_MS, I_NMIX, I_NMEM, I_NMEMTOK, I_NMLP, I_RET_WIN, I_RET_DECAY, I_RET_ONORM, I_RET_WOUT, I_HG_WIN, I_HG_LB, I_HG_ONORM, I_HG_WOUT,
       I_MLA_WIN, I_MLA_QNORM, I_MLA_KVNORM, I_MLA_WQB, I_MLA_WKVB, I_MLA_QKNORM, I_MLA_WOUT, I_GQA_WIN, I_GQA_QKNORM, I_GQA_WOUT, I_MEM_WQ, I_MEM_WKV, I_MEM_QKNORM, I_MEM_WOUT, I_MLP_W1, I_MLP_W2 };

typedef const Params __attribute__((address_space(4))) CParams;
__device__ __forceinline__ CParams* kargs() { CParams* q = (CParams*)__builtin_amdgcn_kernarg_segment_ptr(); asm volatile("" : "+s"(q)); return q; }
#define PIN(i) (kargs()->in[i])
#define POUT (kargs()->out)
#define PWS (kargs()->ws)
struct Frame { LAS unsigned char* lds; int tid, lane, wave, G, gw, NGW, bid; };
__device__ __forceinline__ Frame make_frame(LAS unsigned char* lds) {
    Frame F; int tid = threadIdx.x; asm volatile("" : "+v"(tid));
    F.lds = lds; F.tid = tid; F.lane = tid & 63; F.wave = __builtin_amdgcn_readfirstlane(tid >> 6);
    int G = gridDim.x; asm volatile("" : "+s"(G));
    int bid = blockIdx.x; asm volatile("" : "+s"(bid));
    F.G = G; F.bid = bid; F.gw = bid * NWAVES + F.wave; F.NGW = F.G * NWAVES; return F;
}

__device__ __forceinline__ void transpose_item(const float* W, int K, int N, bf16_t* WT, LAS float* scr, int item, int lane, const float* gain) {
    const int nblk = N / 64, kb = item / nblk, nb = item % nblk, k0 = 64 * kb, n0 = 64 * nb;
    const int lr = lane >> 4, lc = 4 * (lane & 15);
    f32x4 wv[16];
#pragma unroll
    for (int i = 0; i < 16; ++i) wv[i] = __builtin_nontemporal_load((const f32x4*)(W + (size_t)(k0 + 4 * i + lr) * N + n0 + lc));
#pragma unroll
    for (int i = 0; i < 16; ++i) { const int kk = 4 * i + lr; const float g = gain ? gain[k0 + kk] : 1.f;
        *(LAS f32x4*)(scr + kk * 64 + (lc ^ (8 * ((kk >> 3) & 3)))) = wv[i] * g; }
    LDS_WAIT();
    const int c = lane & 7, nl = lane >> 3, sw = 8 * (c & 3);
#pragma unroll
    for (int j = 0; j < 8; ++j) { const int n = nl + 8 * j; const LAS float* sp = scr + (8 * c) * 64 + (n ^ sw);
        u32x4 o; o.x = cvt_pk_bf16(sp[0 * 64], sp[1 * 64]); o.y = cvt_pk_bf16(sp[2 * 64], sp[3 * 64]); o.z = cvt_pk_bf16(sp[4 * 64], sp[5 * 64]); o.w = cvt_pk_bf16(sp[6 * 64], sp[7 * 64]);
        *(u32x4*)(WT + (size_t)(n0 + n) * K + k0 + 8 * c) = o; }
    LDS_WAIT();
}
__device__ __forceinline__ void convert_mat(const Frame& F, const float* W, int K, int N, bf16_t* WT, const float* gain = nullptr) {
    LAS float* scr = (LAS float*)(F.lds + F.wave * 16384);
    const int nitems = (K / 64) * (N / 64);
    for (int rep = 0; rep < REP_CONV; ++rep) for (int it = F.gw; it < nitems; it += F.NGW) transpose_item(W, K, N, WT, scr, it, F.lane, gain);
}
__device__ __forceinline__ void xcopy_rows(const Frame& F, const float* x, bf16_t* xb, float* ssq, int nrows) {
    for (int r = F.gw; r < nrows; r += F.NGW) {
        const f32x4* xr = (const f32x4*)(x + (size_t)r * DM) + F.lane;
        f32x4 v[8]; float s2 = 0.f;
#pragma unroll
        for (int j = 0; j < 8; ++j) { v[j] = __builtin_nontemporal_load(xr + 64 * j); s2 += (v[j].x * v[j].x + v[j].y * v[j].y) + (v[j].z * v[j].z + v[j].w * v[j].w); }
        s2 = wave_sum(s2);
        u32x2* o = (u32x2*)(xb + (size_t)r * DM) + F.lane;
#pragma unroll
        for (int j = 0; j < 8; ++j) { u32x2 w; w.x = cvt_pk_bf16(v[j].x, v[j].y); w.y = cvt_pk_bf16(v[j].z, v[j].w); o[64 * j] = w; }
        if (F.lane < 8) ssq[(size_t)r * 8 + F.lane] = (F.lane == 0) ? s2 : 0.f;
    }
}

__device__ __forceinline__ void norm_rows(const Frame& F, const float* x, const float* gain, bf16_t* out, int nrows) {
    f32x4 gv[8];
#pragma unroll
    for (int j = 0; j < 8; ++j) gv[j] = gain ? ((const f32x4*)gain)[F.lane + 64 * j] : (f32x4){1.f, 1.f, 1.f, 1.f};
    for (int r = F.gw; r < nrows; r += F.NGW) {
        const f32x4* xr = (const f32x4*)(x + (size_t)r * DM) + F.lane;
        f32x4 v[8]; float s = 0.f;
#pragma unroll
        for (int j = 0; j < 8; ++j) { v[j] = xr[64 * j]; s += (v[j].x * v[j].x + v[j].y * v[j].y) + (v[j].z * v[j].z + v[j].w * v[j].w); }
        const float rstd = rsqrtf(wave_sum(s) * (1.f / DM) + EPS);
        u32x2* o = (u32x2*)(out + (size_t)r * DM) + F.lane;
#pragma unroll
        for (int j = 0; j < 8; ++j) { u32x2 w; w.x = cvt_pk_bf16(v[j].x * rstd * gv[j].x, v[j].y * rstd * gv[j].y); w.y = cvt_pk_bf16(v[j].z * rstd * gv[j].z, v[j].w * rstd * gv[j].w); o[64 * j] = w; }
    }
}

template <int RED, bool NORM>
__device__ __forceinline__ void post_pair(const bf16_t* s1, const bf16_t* s2, bf16_t* d1, bf16_t* d2, const float* g1, const float* g2, const float* ct, const float* st, bool rope, float inv_n, float scale, bool active) {
    float a[8], b[8];
    if (active) { ld8(s1, a); ld8(s2, b); } else {
#pragma unroll
        for (int k = 0; k < 8; ++k) { a[k] = 0.f; b[k] = 0.f; } }
    if (NORM) {
        float ss = 0.f;
#pragma unroll
        for (int k = 0; k < 8; ++k) ss += a[k] * a[k] + b[k] * b[k];
#pragma unroll
        for (int o = 1; o < RED; o <<= 1) ss += __shfl_xor(ss, o);
        const float rs = rsqrtf(ss * inv_n + EPS) * scale;
        if (active) {
#pragma unroll
            for (int k = 0; k < 8; ++k) { a[k] *= rs * g1[k]; b[k] *= rs * g2[k]; } }
    } else {
#pragma unroll
        for (int k = 0; k < 8; ++k) { a[k] *= scale; b[k] *= scale; }
    }
    if (active) {
        if (rope) {
#pragma unroll
            for (int k = 0; k < 8; ++k) { const float c = ct[k], s = st[k], na = a[k] * c - b[k] * s, nb = a[k] * s + b[k] * c; a[k] = na; b[k] = nb; } }
        st8(d1, a); st8(d2, b);
    }
}

struct PItem { const bf16_t* s1; const bf16_t* s2; bf16_t* d1; bf16_t* d2; const float* g1; const float* g2; const float* ct; const float* st; float scale; bool rope, active; };
template <int RED, bool NORM, int U, class MK>
__device__ __forceinline__ void post_loop(long gtid0, long nth, long total, float inv_n, MK mk) {
    for (long g0 = gtid0; g0 < total; g0 += nth * U) {
        PItem it[U]; float a[U][8], b[U][8];
#pragma unroll
        for (int u = 0; u < U; ++u) { const long gt = g0 + u * nth; const bool ok = gt < total; it[u] = mk(ok ? gt : g0); it[u].active = it[u].active && ok;
            if (it[u].active) { ld8(it[u].s1, a[u]); ld8(it[u].s2, b[u]); } else {
#pragma unroll
                for (int k = 0; k < 8; ++k) { a[u][k] = 0.f; b[u][k] = 0.f; } } }
#pragma unroll
        for (int u = 0; u < U; ++u) {
            float rs = it[u].scale;
            if (NORM) { float ss = 0.f;
#pragma unroll
                for (int k = 0; k < 8; ++k) ss += a[u][k] * a[u][k] + b[u][k] * b[u][k];
#pragma unroll
                for (int o = 1; o < RED; o <<= 1) ss += __shfl_xor(ss, o);
                rs *= rsqrtf(ss * inv_n + EPS); }
            if (it[u].active) {
#pragma unroll
                for (int k = 0; k < 8; ++k) { a[u][k] *= NORM ? rs * it[u].g1[k] : rs; b[u][k] *= NORM ? rs * it[u].g2[k] : rs; }
                if (it[u].rope) {
#pragma unroll
                    for (int k = 0; k < 8; ++k) { const float c = it[u].ct[k], sn = it[u].st[k], na = a[u][k] * c - b[u][k] * sn, nb = a[u][k] * sn + b[u][k] * c; a[u][k] = na; b[u][k] = nb; } }
                st8(it[u].d1, a[u]); st8(it[u].d2, b[u]);
            }
        }
    }
}

template <int LANES>
__device__ __forceinline__ void combine_rows(const Frame& F, const bf16_t* A, int lda, const bf16_t* B, const bf16_t* gate, int ldg, const float* gain, bf16_t* dst, int ldd, int heads, long nvec) {
    constexpr int HD = 16 * LANES;
    const long nth = (long)F.G * NTHREADS;
    for (long gt = (long)F.bid * NTHREADS + F.tid; gt < nvec * LANES; gt += nth) {
        const long hv = gt / LANES; const int j = (int)(gt % LANES); const long t = hv / heads; const int h = (int)(hv % heads); const int e0 = h * HD + 16 * j;
        float a[16], gt_[16];
        { float t0[8], t1[8]; ld8(A + t * lda + e0, t0); ld8(A + t * lda + e0 + 8, t1);
#pragma unroll
          for (int k = 0; k < 8; ++k) { a[k] = t0[k]; a[8 + k] = t1[k]; } }
        if (B) { float t0[8], t1[8]; ld8(B + t * lda + e0, t0); ld8(B + t * lda + e0 + 8, t1);
#pragma unroll
          for (int k = 0; k < 8; ++k) { a[k] += t0[k]; a[8 + k] += t1[k]; } }
        { float t0[8], t1[8]; ld8(gate + t * ldg + e0, t0); ld8(gate + t * ldg + e0 + 8, t1);
#pragma unroll
          for (int k = 0; k < 8; ++k) { gt_[k] = t0[k]; gt_[8 + k] = t1[k]; } }
        float ss = 0.f;
#pragma unroll
        for (int k = 0; k < 16; ++k) ss += a[k] * a[k];
#pragma unroll
        for (int o = 1; o < LANES; o <<= 1) ss += __shfl_xor(ss, o);
        const float rs = rsqrtf(ss * (1.f / HD) + EPS);
        float o0[8], o1[8];
#pragma unroll
        for (int k = 0; k < 8; ++k) { const float g0 = gt_[k], g1 = gt_[8 + k];
            o0[k] = a[k] * rs * gain[16 * j + k] * (g0 * sigmoidf_(g0)); o1[k] = a[8 + k] * rs * gain[16 * j + 8 + k] * (g1 * sigmoidf_(g1)); }
        st8(dst + t * ldd + e0, o0); st8(dst + t * ldd + e0 + 8, o1);
    }
}

#define KSWZ(row, colB, ROWB) ((row) * (ROWB) + ((colB) ^ (((row) & 7) << 4)))
__device__ __forceinline__ int crow(int r, int hi) { return (r & 3) + 8 * (r >> 2) + 4 * hi; }
__device__ __forceinline__ int v_st(int k, int c) { const int kk = (k & ~0xC) | ((k & 4) << 1) | ((k & 8) >> 1); return ((kk >> 3) * 4 + (c >> 5)) * 512 + ((kk & 7) * 32 + (c & 31)) * 2; }
__device__ __forceinline__ int v_rd_base(int lane) { return ((lane & 3) << 3) | (((lane >> 2) & 3) << 6) | (((lane >> 4) & 1) << 5) | (((lane >> 5) & 1) << 8); }
constexpr int v_rd_off(int d0, int ks, int half) { return d0 * 512 + ks * 4096 + half * 2048; }
template <int OFF> __device__ __forceinline__ s16x4 tr_read(int vb) { s16x4 r; asm volatile("ds_read_b64_tr_b16 %0, %1 offset:%2" : "=&v"(r) : "v"(vb), "i"(OFF) : "memory"); return r; }
template <int D0> __device__ __forceinline__ void pv_one(f32x16& od, int vb, bf16x8 pa0, bf16x8 pa1, bf16x8 pa2, bf16x8 pa3) {
    const s16x4 l0 = tr_read<v_rd_off(D0, 0, 0)>(vb), h0 = tr_read<v_rd_off(D0, 0, 1)>(vb), l1 = tr_read<v_rd_off(D0, 1, 0)>(vb), h1 = tr_read<v_rd_off(D0, 1, 1)>(vb);
    const s16x4 l2 = tr_read<v_rd_off(D0, 2, 0)>(vb), h2 = tr_read<v_rd_off(D0, 2, 1)>(vb), l3 = tr_read<v_rd_off(D0, 3, 0)>(vb), h3 = tr_read<v_rd_off(D0, 3, 1)>(vb);
    asm volatile("s_waitcnt lgkmcnt(0)" ::: "memory"); __builtin_amdgcn_sched_barrier(0);
#define PKV(L, H) (bf16x8){L[0], L[1], L[2], L[3], H[0], H[1], H[2], H[3]}
    od = __builtin_amdgcn_mfma_f32_32x32x16_bf16(pa0, PKV(l0, h0), od, 0, 0, 0);
    od = __builtin_amdgcn_mfma_f32_32x32x16_bf16(pa1, PKV(l1, h1), od, 0, 0, 0);
    od = __builtin_amdgcn_mfma_f32_32x32x16_bf16(pa2, PKV(l2, h2), od, 0, 0, 0);
    od = __builtin_amdgcn_mfma_f32_32x32x16_bf16(pa3, PKV(l3, h3), od, 0, 0, 0);
#undef PKV
}
template <int D0, int KS0> __device__ __forceinline__ void pv_half(f32x16& od, int vb, bf16x8 paA, bf16x8 paB) {
    const s16x4 l0 = tr_read<v_rd_off(D0, KS0, 0)>(vb), h0 = tr_read<v_rd_off(D0, KS0, 1)>(vb), l1 = tr_read<v_rd_off(D0, KS0 + 1, 0)>(vb), h1 = tr_read<v_rd_off(D0, KS0 + 1, 1)>(vb);
    asm volatile("s_waitcnt lgkmcnt(0)" ::: "memory"); __builtin_amdgcn_sched_barrier(0);
#define PKV(L, H) (bf16x8){L[0], L[1], L[2], L[3], H[0], H[1], H[2], H[3]}
    od = __builtin_amdgcn_mfma_f32_32x32x16_bf16(paA, PKV(l0, h0), od, 0, 0, 0);
    od = __builtin_amdgcn_mfma_f32_32x32x16_bf16(paB, PKV(l1, h1), od, 0, 0, 0);
#undef PKV
}
#define PK4(P, BASE, OUT) do { unsigned a0 = cvt_pk_bf16(P[BASE + 0], P[BASE + 1]), a1 = cvt_pk_bf16(P[BASE + 2], P[BASE + 3]);   \
    unsigned b0 = cvt_pk_bf16(P[BASE + 4], P[BASE + 5]), b1 = cvt_pk_bf16(P[BASE + 6], P[BASE + 7]);                              \
    auto r0 = __builtin_amdgcn_permlane32_swap(a0, b0, false, false); auto r1 = __builtin_amdgcn_permlane32_swap(a1, b1, false, false); \
    u32x4 w = {r0[0], r1[0], r0[1], r1[1]}; OUT = *reinterpret_cast<bf16x8*>(&w); } while (0)

template <int DK, int MODE, int QMODE>
__device__ __forceinline__ void attn_unit(const bf16_t* __restrict__ Qb, int ldq, const bf16_t* __restrict__ Kh, int ldk, const bf16_t* __restrict__ Vh, int ldv,
                                          bf16_t* __restrict__ Ob, int ldo, int nkeys, float C, float lgf2, float lgb2, int qpos0, LAS char* lds, const float* qg, const float* tcos, const float* tsin) {
    constexpr int ROWB = DK * 2, KTB = 64 * ROWB, NQ = DK / 16, KCH = DK / 64, CPR = DK / 8;
    int tid = threadIdx.x; asm volatile("" : "+v"(tid));
    const int wid = __builtin_amdgcn_readfirstlane(tid >> 6), lane = tid & 63, r32 = lane & 31, hi = lane >> 5;
    LAS char* V_lds = lds; LAS char* K_lds = lds + 3 * 16384;
    LAS float* wsf = (LAS float*)(lds + 3 * 16384 + 3 * KTB) + wid * 64; LAS float* li_l = wsf; LAS float* al_l = wsf + 32;
    float m_reg = -1e30f, l_reg = 0.f; f32x16 o[4];
#pragma unroll
    for (int d = 0; d < 4; ++d)
#pragma unroll
        for (int r = 0; r < 16; ++r) o[d][r] = 0.f;
    bf16x8 qr[NQ];
    { const bf16_t* Qw = Qb + (size_t)(wid * 32 + r32) * ldq + hi * 8;
#pragma unroll
      for (int d0 = 0; d0 < NQ; ++d0) qr[d0] = *(const bf16x8*)(Qw + d0 * 16); }
    if (QMODE != 0) {
#define Q_UNPK(D0, F) do { const u32x4 w4_ = *reinterpret_cast<const u32x4*>(&qr[D0]); F[0] = bf_lo(w4_.x); F[1] = bf_hi(w4_.x); F[2] = bf_lo(w4_.y); F[3] = bf_hi(w4_.y); F[4] = bf_lo(w4_.z); F[5] = bf_hi(w4_.z); F[6] = bf_lo(w4_.w); F[7] = bf_hi(w4_.w); } while (0)
#define Q_PACK(D0, F) do { u32x4 w4_; w4_.x = cvt_pk_bf16(F[0], F[1]); w4_.y = cvt_pk_bf16(F[2], F[3]); w4_.z = cvt_pk_bf16(F[4], F[5]); w4_.w = cvt_pk_bf16(F[6], F[7]); qr[D0] = *reinterpret_cast<bf16x8*>(&w4_); } while (0)
#define Q_GAIN(D0, F) do { const f32x4 g0_ = *(const f32x4*)(qg + (D0) * 16 + hi * 8), g1_ = *(const f32x4*)(qg + (D0) * 16 + hi * 8 + 4); _Pragma("unroll") for (int k = 0; k < 4; ++k) { F[k] *= rs * g0_[k]; F[4 + k] *= rs * g1_[k]; } } while (0)
        float ss = 0.f;
#pragma unroll
        for (int d0 = 0; d0 < NQ; ++d0) { float f[8]; Q_UNPK(d0, f);
#pragma unroll
            for (int k = 0; k < 8; ++k) ss += f[k] * f[k]; }
        ss += __shfl_xor(ss, 32);
        const float rs = rsqrtf(ss * (1.f / DK) + EPS);
        const int tpos = qpos0 + wid * 32 + r32;
#pragma unroll
        for (int d0 = 0; d0 < NQ; ++d0) {
            const bool first = (QMODE == 2) ? ((d0 & 2) == 0) : (QMODE == 3) ? (d0 == 8 || d0 == 9) : false;
            const bool second = (QMODE == 2) ? ((d0 & 2) != 0) : (QMODE == 3) ? (d0 == 10 || d0 == 11) : false;
            if (second) continue;
            float f[8]; Q_UNPK(d0, f); Q_GAIN(d0, f);
            if (first) { float f2[8]; Q_UNPK(d0 + 2, f2); Q_GAIN(d0 + 2, f2);
                const int dd = d0 & 1; const int pos = (QMODE == 2) ? ((d0 & 4) ? (tpos & 63) : (tpos >> 6)) : tpos;
                const float* cp = tcos + pos * 32 + dd * 16 + hi * 8; const float* sp = tsin + pos * 32 + dd * 16 + hi * 8;
#pragma unroll
                for (int k = 0; k < 8; ++k) { const float c = cp[k], sn = sp[k], x1 = f[k], x2 = f2[k]; f[k] = x1 * c - x2 * sn; f2[k] = x1 * sn + x2 * c; }
                Q_PACK(d0 + 2, f2); }
            Q_PACK(d0, f);
        }
#undef Q_UNPK
#undef Q_PACK
#undef Q_GAIN
    }
    const int vb0 = (int)(uintptr_t)V_lds + v_rd_base(lane);
    unsigned koff[KCH], voff[2];
#pragma unroll
    for (int i = 0; i < KCH; ++i) { const int p = (i * 8 + wid) * 64 + lane, row = p / CPR, cc = (p % CPR) ^ (row & 7); koff[i] = (unsigned)(row * ldk + cc * 8) * 2u; }
#pragma unroll
    for (int i = 0; i < 2; ++i) { const int p = (i * 8 + wid) * 64 + lane, sub = p >> 5, kk = (sub >> 2) * 8 + ((p & 31) >> 2), c = (sub & 3) * 32 + (p & 3) * 8;
        const int k = (kk & ~0xC) | ((kk & 4) << 1) | ((kk & 8) >> 1); voff[i] = (unsigned)(k * ldv + c) * 2u; }
#define A_DMA(k0, b) do { const char* kb_ = (const char*)(Kh + (size_t)(k0) * ldk); const char* vb_ = (const char*)(Vh + (size_t)(k0) * ldv); \
    _Pragma("unroll") for (int i = 0; i < KCH; ++i) __builtin_amdgcn_global_load_lds((const unsigned*)(kb_ + koff[i]), (LAS unsigned*)(K_lds + (b) * KTB + (i * 8 + wid) * 1024), 16, 0, 0); \
    _Pragma("unroll") for (int i = 0; i < 2; ++i) __builtin_amdgcn_global_load_lds((const unsigned*)(vb_ + voff[i]), (LAS unsigned*)(V_lds + (b) * 16384 + (i * 8 + wid) * 1024), 16, 0, 0); } while (0)
    const int NT = nkeys / 64;
    const float thr_raw = (MODE == 0) ? 8.0f * 1.4426950408889634f / C : 0.f;
#define A_BAR() do { asm volatile("s_waitcnt lgkmcnt(0)" ::: "memory"); __builtin_amdgcn_s_barrier(); asm volatile("" ::: "memory"); } while (0)
    A_DMA(0, 0);
    if (NT > 1) { A_DMA(64, 1); asm volatile("s_waitcnt vmcnt(%0)" :: "n"(KCH + 2) : "memory"); } else asm volatile("s_waitcnt vmcnt(0)" ::: "memory");
    A_BAR();
    int buf = 0;
    for (int j = 0; j < NT; ++j) {
        if (j + 2 < NT) A_DMA((j + 2) * 64, (buf == 0 ? 2 : buf - 1));
        __builtin_amdgcn_sched_barrier(0);
        LAS const char* Ks = K_lds + buf * KTB;
        bf16x8 pa0 = {}, pa1 = {}, pa2 = {}, pa3 = {};
        if (MODE == 0) {
            f32x16 p0, p1;
#pragma unroll
            for (int r = 0; r < 16; ++r) { p0[r] = 0.f; p1[r] = 0.f; }
#pragma unroll
            for (int d0 = 0; d0 < NQ; ++d0) { const int cb = (d0 * 16 + hi * 8) * 2;
                const bf16x8 b0 = *(LAS const bf16x8*)(Ks + KSWZ(r32, cb, ROWB));
                const bf16x8 b1 = *(LAS const bf16x8*)(Ks + KSWZ(32 + r32, cb, ROWB));
                p0 = __builtin_amdgcn_mfma_f32_32x32x16_bf16(b0, qr[d0], p0, 0, 0, 0);
                p1 = __builtin_amdgcn_mfma_f32_32x32x16_bf16(b1, qr[d0], p1, 0, 0, 0); }
            float pmax = p0[0];
#pragma unroll
            for (int r = 1; r < 16; ++r) pmax = fmaxf(pmax, p0[r]);
#pragma unroll
            for (int r = 0; r < 16; ++r) pmax = fmaxf(pmax, p1[r]);
            { auto rr = __builtin_amdgcn_permlane32_swap(__float_as_uint(pmax), __float_as_uint(pmax), false, false); pmax = fmaxf(__uint_as_float(rr[0]), __uint_as_float(rr[1])); }
            float alpha = 1.f;
            if (!__all(pmax - m_reg <= thr_raw)) { const float mn = fmaxf(m_reg, pmax); alpha = __builtin_amdgcn_exp2f((m_reg - mn) * C); m_reg = mn; }
            const float mnC = -m_reg * C;
#pragma unroll
            for (int r = 0; r < 16; ++r) { p0[r] = __builtin_amdgcn_exp2f(fmaf(p0[r], C, mnC)); p1[r] = __builtin_amdgcn_exp2f(fmaf(p1[r], C, mnC)); }
            float ps = 0.f;
#pragma unroll
            for (int r = 0; r < 16; ++r) ps += p0[r] + p1[r];
            { auto rr = __builtin_amdgcn_permlane32_swap(__float_as_uint(ps), __float_as_uint(ps), false, false); ps = __uint_as_float(rr[0]) + __uint_as_float(rr[1]); }
            l_reg = l_reg * alpha + ps;
            if (__any(alpha < 1.f)) { if (hi == 0) al_l[r32] = alpha; asm volatile("s_waitcnt lgkmcnt(0)" ::: "memory");
#pragma unroll
                for (int r = 0; r < 16; ++r) { const float al = al_l[crow(r, hi)];
#pragma unroll
                    for (int d = 0; d < 4; ++d) o[d][r] *= al; } }
            PK4(p0, 0, pa0); PK4(p0, 8, pa1); PK4(p1, 0, pa2); PK4(p1, 8, pa3);
        } else {
            const float tq = (float)(qpos0 + wid * 32 + r32 - 64 * j);
#pragma unroll
            for (int hh = 0; hh < 2; ++hh) {
                f32x16 p;
#pragma unroll
                for (int r = 0; r < 16; ++r) p[r] = 0.f;
#pragma unroll
                for (int d0 = 0; d0 < NQ; ++d0) { const int cb = (d0 * 16 + hi * 8) * 2;
                    if ((d0 & 3) == 0) __builtin_amdgcn_sched_barrier(0);
                    const bf16x8 b0 = *(LAS const bf16x8*)(Ks + KSWZ(32 * hh + r32, cb, ROWB));
                    p = __builtin_amdgcn_mfma_f32_32x32x16_bf16(b0, qr[d0], p, 0, 0, 0); }
#pragma unroll
                for (int r = 0; r < 16; ++r) {
                    const float dd = tq - (float)(crow(r, hi) + 32 * hh);
                    const float w = (dd == 0.f) ? 2.f : __builtin_amdgcn_exp2f(dd * (dd > 0.f ? lgf2 : -lgb2));
                    p[r] *= w; }
                bf16x8 paA, paB; PK4(p, 0, paA); PK4(p, 8, paB);
                const int vb = vb0 + buf * 16384;
                if (hh == 0) { pv_half<0, 0>(o[0], vb, paA, paB); pv_half<1, 0>(o[1], vb, paA, paB); pv_half<2, 0>(o[2], vb, paA, paB); pv_half<3, 0>(o[3], vb, paA, paB); }
                else         { pv_half<0, 2>(o[0], vb, paA, paB); pv_half<1, 2>(o[1], vb, paA, paB); pv_half<2, 2>(o[2], vb, paA, paB); pv_half<3, 2>(o[3], vb, paA, paB); }
            }
        }
        if (MODE == 0) { const int vb = vb0 + buf * 16384;
          pv_one<0>(o[0], vb, pa0, pa1, pa2, pa3); pv_one<1>(o[1], vb, pa0, pa1, pa2, pa3); pv_one<2>(o[2], vb, pa0, pa1, pa2, pa3); pv_one<3>(o[3], vb, pa0, pa1, pa2, pa3); }
        if (j + 2 < NT) asm volatile("s_waitcnt vmcnt(%0)" :: "n"(KCH + 2) : "memory"); else asm volatile("s_waitcnt vmcnt(0)" ::: "memory");
        A_BAR();
        buf = (buf == 2) ? 0 : buf + 1;
    }
    float rli[16];
    if (MODE == 0) {
        if (hi == 0) li_l[r32] = l_reg; asm volatile("s_waitcnt lgkmcnt(0)" ::: "memory");
#pragma unroll
        for (int r = 0; r < 16; ++r) rli[r] = __builtin_amdgcn_rcpf(li_l[crow(r, hi)]);
    } else {
#pragma unroll
        for (int r = 0; r < 16; ++r) rli[r] = 1.f;
    }
    bf16_t* Ow = Ob + (size_t)(wid * 32) * ldo;
#pragma unroll
    for (int r = 0; r < 16; ++r) { const int orow = crow(r, hi);
#pragma unroll
        for (int d0 = 0; d0 < 4; ++d0) { const float v = o[d0][r] * rli[r]; Ow[(size_t)orow * ldo + d0 * 32 + r32] = (bf16_t)(cvt_pk_bf16(v, v) & 0xffffu); } }
#undef A_DMA
#undef A_BAR
}

template <int DK, int MODE, int QMODE>
__device__ __forceinline__ void attn_phase(const Frame& F, const bf16_t* Q, int ldq, int qhs, const bf16_t* K, int ldk, int khs, const bf16_t* V, int ldv, int vhs, bf16_t* O, int ldo, int ohs,
                                           int nb, int nheads, int gq, int nslice, int sq, int skv, float C, const float* decay, const float* qg, const float* tcos, const float* tsin) {
    const int nqb = sq / 256, units = nb * nheads * nslice * nqb;
    const int vcu = (F.G % 8 == 0) ? (F.bid % 8) * (F.G / 8) + F.bid / 8 : F.bid;
    for (int u = vcu; u < units; u += F.G) {
        const int qb = u % nqb; int r = u / nqb; const int sl = r % nslice; r /= nslice; const int h = r % nheads; const int b = r / nheads; const int kvh = h / gq;
        float lgf2 = 0.f, lgb2 = 0.f;
        if (MODE == 1) { lgf2 = -log1pf(expf(-decay[h])) * 1.4426950408889634f; lgb2 = -log1pf(expf(-decay[8 + h])) * 1.4426950408889634f; }
        attn_unit<DK, MODE, QMODE>(Q + (size_t)(b * sq + qb * 256) * ldq + h * qhs, ldq, K + (size_t)(b * skv) * ldk + kvh * khs, ldk, V + (size_t)(b * skv) * ldv + kvh * vhs + sl * 128, ldv,
                            O + (size_t)(b * sq + qb * 256) * ldo + h * ohs + sl * 128, ldo, skv, C, lgf2, lgb2, qb * 256, (LAS char*)F.lds, qg, tcos, tsin);
        __syncthreads();
    }
}

__device__ __forceinline__ unsigned off_b(unsigned row, unsigned ch) { return 256u * row + 16u * (ch ^ (((row & 3) << 2) | ((row >> 2) & 3))); }
__device__ __forceinline__ unsigned rr16(unsigned lane, unsigned rb, unsigned s) { return off_b((lane & 15) + 16 * rb, 4 * s + (lane >> 4)); }
__device__ __forceinline__ unsigned tr16(unsigned lane, unsigned c, unsigned t) { const unsigned g = lane >> 4, q = (lane & 15) >> 2, p = lane & 3; return off_b(8 * g + 4 * t + q, 2 * c + (p >> 1)) + 8 * (p & 1); }
__device__ __forceinline__ s16x4 tr_rd(unsigned addr) { return __builtin_amdgcn_ds_read_tr16_b64_v4i16((LAS s16x4*)(uintptr_t)addr); }
#define TRWAIT() do { } while (0)
#define PK2T(L, H) (bf16x8){L[0], L[1], L[2], L[3], H[0], H[1], H[2], H[3]}

__device__ __forceinline__ void hg_scan_item(const Frame& F, const bf16_t* big, const float* hg_lb, bf16_t* outp, int b, int h, int dir) {
    constexpr unsigned O_QT = 0, O_KT = 8192, O_KS = 16384, O_VV = 24576, O_ST = 40960, O_SS = 73728, O_TOT = 75776, O_EBL = 79872;
    constexpr int NCH = SEQ / 32;
    LAS char* L = (LAS char*)F.lds;
    int tid = F.tid; asm volatile("" : "+v"(tid));
    const int lane = tid & 63, w = __builtin_amdgcn_readfirstlane(tid >> 6), fq = lane >> 4, fr = lane & 15;
    const int et_ = tid >> 4, c8 = tid & 15, tl = lane >> 4;
    const unsigned lbase = (unsigned)(uintptr_t)L;
    float lb8[8];
#pragma unroll
    for (int k = 0; k < 8; ++k) { const int d = h * 128 + 8 * c8 + k; const float l0 = hg_lb[d], l1 = hg_lb[2048 + d], l2 = hg_lb[4096 + d], l3 = hg_lb[6144 + d];
        const float mx = fmaxf(fmaxf(l0, l1), fmaxf(l2, l3)); const float e0 = expf(l0 - mx), e1 = expf(l1 - mx), e2 = expf(l2 - mx), e3 = expf(l3 - mx);
        lb8[k] = e1 / (e0 + e1 + e2 + e3); }
#pragma unroll
    for (int i = 0; i < 4; ++i) *(LAS u32x4*)(L + O_ST + (tid + 512 * i) * 16) = (u32x4){0u, 0u, 0u, 0u};
    f32x4 S[8];
#pragma unroll
    for (int i = 0; i < 8; ++i) S[i] = (f32x4){0.f, 0.f, 0.f, 0.f};
    const size_t rowbase = (size_t)b * SEQ;
    const int colq = h * 128 + 8 * c8, colf = 2048 + dir * 2048 + h * 128 + 8 * c8;
    const int vrow = 4 * w + tl; const int vch = fr ^ (((vrow & 3) << 2) | ((vrow >> 2) & 3)); const int colv = 6144 + h * 128 + 8 * vch;
#define HG_BAR() do { asm volatile("s_waitcnt lgkmcnt(0)" ::: "memory"); __builtin_amdgcn_s_barrier(); asm volatile("" ::: "memory"); } while (0)
#define HG_TOK(p) (dir ? (SEQ - 1 - (p)) : (p))
#define HG_LOADQF(c) do { const bf16_t* row_ = big + (rowbase + HG_TOK((c) * 32 + et_)) * 10240; qv = *(const u32x4*)(row_ + colq); fv = *(const u32x4*)(row_ + colf); } while (0)
#define HG_DMAV(c, buf) __builtin_amdgcn_global_load_lds((const unsigned*)(big + (rowbase + HG_TOK((c) * 32 + vrow)) * 10240 + colv), (LAS unsigned*)(L + O_VV + (buf) * 8192 + w * 1024), 16, 0, 0)
    u32x4 qv, fv; float q8[8], f8[8], x8[8];
#define HG_E1() do { float fz_[8]; fz_[0] = bf_lo(fv.x); fz_[1] = bf_hi(fv.x); fz_[2] = bf_lo(fv.y); fz_[3] = bf_hi(fv.y); fz_[4] = bf_lo(fv.z); fz_[5] = bf_hi(fv.z); fz_[6] = bf_lo(fv.w); fz_[7] = bf_hi(fv.w); \
        q8[0] = bf_lo(qv.x); q8[1] = bf_hi(qv.x); q8[2] = bf_lo(qv.y); q8[3] = bf_hi(qv.y); q8[4] = bf_lo(qv.z); q8[5] = bf_hi(qv.z); q8[6] = bf_lo(qv.w); q8[7] = bf_hi(qv.w); \
        _Pragma("unroll") for (int k = 0; k < 8; ++k) { f8[k] = lb8[k] + (1.f - lb8[k]) * sigmoidf_(fz_[k]); x8[k] = f8[k]; } \
        _Pragma("unroll") for (int k = 0; k < 8; ++k) { const float y_ = __shfl_up(x8[k], 16); x8[k] = (tl >= 1) ? x8[k] * y_ : x8[k]; } \
        _Pragma("unroll") for (int k = 0; k < 8; ++k) { const float y_ = __shfl_up(x8[k], 32); x8[k] = (tl >= 2) ? x8[k] * y_ : x8[k]; } \
        if (tl == 3) { *(LAS f32x4*)(L + O_TOT + (w * 128 + 8 * c8) * 4) = (f32x4){x8[0], x8[1], x8[2], x8[3]}; *(LAS f32x4*)(L + O_TOT + (w * 128 + 8 * c8 + 4) * 4) = (f32x4){x8[4], x8[5], x8[6], x8[7]}; } } while (0)
    HG_LOADQF(0); HG_DMAV(0, 0);
    HG_E1(); asm volatile("s_waitcnt vmcnt(0)" ::: "memory");
    for (int c = 0; c < NCH; ++c) {
        const int buf = c & 1;
        asm volatile("s_waitcnt vmcnt(2)" ::: "memory");
        HG_BAR();
        if (c > 0) {
#pragma unroll
            for (int et = 0; et < 8; ++et) { u32x2 v2; v2.x = cvt_pk_bf16(S[et][0], S[et][1]); v2.y = cvt_pk_bf16(S[et][2], S[et][3]);
                *(LAS u32x2*)(L + O_ST + off_b(16 * et + fr, 2 * w + (fq >> 1)) + 8 * (fq & 1)) = v2; }
        }
        {
            float pre[8], all[8];
#pragma unroll
            for (int k = 0; k < 8; ++k) { pre[k] = 1.f; all[k] = 1.f; }
#pragma unroll
            for (int w2 = 0; w2 < 8; ++w2) { const f32x4 t0 = *(LAS const f32x4*)(L + O_TOT + (w2 * 128 + 8 * c8) * 4), t1 = *(LAS const f32x4*)(L + O_TOT + (w2 * 128 + 8 * c8 + 4) * 4);
#pragma unroll
                for (int k = 0; k < 4; ++k) { all[k] *= t0[k]; all[4 + k] *= t1[k]; if (w2 < w) { pre[k] *= t0[k]; pre[4 + k] *= t1[k]; } } }
            float qt[8], kt[8], ks[8];
#pragma unroll
            for (int k = 0; k < 8; ++k) { const float eb = x8[k] * pre[k]; qt[k] = q8[k] * eb; kt[k] = (1.f - f8[k]) * __builtin_amdgcn_rcpf(eb); ks[k] = kt[k] * all[k]; }
            const unsigned o = off_b(et_, c8);
            u32x4 wv; wv.x = cvt_pk_bf16(qt[0], qt[1]); wv.y = cvt_pk_bf16(qt[2], qt[3]); wv.z = cvt_pk_bf16(qt[4], qt[5]); wv.w = cvt_pk_bf16(qt[6], qt[7]); *(LAS u32x4*)(L + O_QT + o) = wv;
            wv.x = cvt_pk_bf16(kt[0], kt[1]); wv.y = cvt_pk_bf16(kt[2], kt[3]); wv.z = cvt_pk_bf16(kt[4], kt[5]); wv.w = cvt_pk_bf16(kt[6], kt[7]); *(LAS u32x4*)(L + O_KT + o) = wv;
            wv.x = cvt_pk_bf16(ks[0], ks[1]); wv.y = cvt_pk_bf16(ks[2], ks[3]); wv.z = cvt_pk_bf16(ks[4], ks[5]); wv.w = cvt_pk_bf16(ks[6], ks[7]); *(LAS u32x4*)(L + O_KS + o) = wv;
            if (tid < 16) { *(LAS f32x4*)(L + O_EBL + (8 * c8) * 4) = (f32x4){all[0], all[1], all[2], all[3]}; *(LAS f32x4*)(L + O_EBL + (8 * c8 + 4) * 4) = (f32x4){all[4], all[5], all[6], all[7]}; }
        }
        if (c + 1 < NCH) { HG_LOADQF(c + 1); HG_DMAV(c + 1, buf ^ 1); }
        HG_BAR();
        if (w < 4) {
            const int jt = w >> 1, it = w & 1; f32x4 a = {0.f, 0.f, 0.f, 0.f};
#pragma unroll
            for (int s4 = 0; s4 < 4; ++s4) { const bf16x8 xk = *(LAS const bf16x8*)(L + O_KT + rr16(lane, jt, s4)), yq = *(LAS const bf16x8*)(L + O_QT + rr16(lane, it, s4));
                a = __builtin_amdgcn_mfma_f32_16x16x32_bf16(xk, yq, a, 0, 0, 0); }
            const int ig = 16 * it + fr, jg = 16 * jt + 4 * fq;
#pragma unroll
            for (int r = 0; r < 4; ++r) a[r] = (jg + r <= ig) ? a[r] : 0.f;
            u32x2 v2; v2.x = cvt_pk_bf16(a[0], a[1]); v2.y = cvt_pk_bf16(a[2], a[3]);
            *(LAS u32x2*)(L + O_SS + ig * 64 + jg * 2) = v2;
        }
        HG_BAR();
        {
            const unsigned vb = lbase + O_VV + buf * 8192;
            const s16x4 v0 = tr_rd(vb + tr16(lane, w, 0)), v1 = tr_rd(vb + tr16(lane, w, 1));
            bf16x8 xd[4];
#pragma unroll
            for (int s4 = 0; s4 < 4; ++s4) xd[s4] = *(LAS const bf16x8*)(L + O_ST + rr16(lane, w, s4));
            TRWAIT();
            const bf16x8 xs = PK2T(v0, v1);
#pragma unroll
            for (int it = 0; it < 2; ++it) {
                const bf16x8 ys = *(LAS const bf16x8*)(L + O_SS + (16 * it + fr) * 64 + fq * 16);
                f32x4 a = {0.f, 0.f, 0.f, 0.f};
                a = __builtin_amdgcn_mfma_f32_16x16x32_bf16(xs, ys, a, 0, 0, 0);
#pragma unroll
                for (int s4 = 0; s4 < 4; ++s4) { const bf16x8 yq = *(LAS const bf16x8*)(L + O_QT + rr16(lane, it, s4)); a = __builtin_amdgcn_mfma_f32_16x16x32_bf16(xd[s4], yq, a, 0, 0, 0); }
                u32x2 v2; v2.x = cvt_pk_bf16(a[0], a[1]); v2.y = cvt_pk_bf16(a[2], a[3]);
                *(u32x2*)(outp + (rowbase + HG_TOK(c * 32 + 16 * it + fr)) * 2048 + h * 128 + 16 * w + 4 * fq) = v2;
            }
        }
        {
            const unsigned vb = lbase + O_VV + buf * 8192, kb = lbase + O_KS;
            const s16x4 k0 = tr_rd(kb + tr16(lane, w, 0)), k1 = tr_rd(kb + tr16(lane, w, 1));
            const f32x4 e4 = *(LAS const f32x4*)(L + O_EBL + (16 * w + 4 * fq) * 4);
            TRWAIT();
            const bf16x8 xk = PK2T(k0, k1);
#pragma unroll
            for (int hb = 0; hb < 2; ++hb) {
                s16x4 va[4], vc[4];
#pragma unroll
                for (int e4i = 0; e4i < 4; ++e4i) { va[e4i] = tr_rd(vb + tr16(lane, 4 * hb + e4i, 0)); vc[e4i] = tr_rd(vb + tr16(lane, 4 * hb + e4i, 1)); }
                TRWAIT();
#pragma unroll
                for (int e4i = 0; e4i < 4; ++e4i) { const int et = 4 * hb + e4i; S[et] = S[et] * e4; S[et] = __builtin_amdgcn_mfma_f32_16x16x32_bf16(xk, PK2T(va[e4i], vc[e4i]), S[et], 0, 0, 0); }
            }
        }
        if (c + 1 < NCH) HG_E1();
    }
    asm volatile("s_waitcnt vmcnt(0)" ::: "memory");
    __syncthreads();
#undef HG_TOK
#undef HG_BAR
#undef HG_LOADQF
#undef HG_DMAV
#undef HG_E1
}

__device__ __forceinline__ void hg_scan2_item(const Frame& F, const bf16_t* big, const float* hg_lb, bf16_t* outp, int b, int h, int dir) {
    constexpr unsigned O_QT = 0, O_KT = 16384, O_KS = 32768, O_VV = 49152, O_SS = 81920, O_TOT = 86016, O_EBL = 94208;
    constexpr int NIT = SEQ / 64;
    LAS char* L = (LAS char*)F.lds;
    int tid = F.tid; asm volatile("" : "+v"(tid));
    const int lane = tid & 63, w = __builtin_amdgcn_readfirstlane(tid >> 6), fq = lane >> 4, fr = lane & 15;
    const int et_ = tid >> 4, c8 = tid & 15, tl = lane >> 4;
    const unsigned lbase = (unsigned)(uintptr_t)L;
    float lb8[8];
#pragma unroll
    for (int k = 0; k < 8; ++k) { const int d = h * 128 + 8 * c8 + k; const float l0 = hg_lb[d], l1 = hg_lb[2048 + d], l2 = hg_lb[4096 + d], l3 = hg_lb[6144 + d];
        const float mx = fmaxf(fmaxf(l0, l1), fmaxf(l2, l3)); const float e0 = expf(l0 - mx), e1 = expf(l1 - mx), e2 = expf(l2 - mx), e3 = expf(l3 - mx);
        lb8[k] = e1 / (e0 + e1 + e2 + e3); }
    f32x4 S[8];
#pragma unroll
    for (int i = 0; i < 8; ++i) S[i] = (f32x4){0.f, 0.f, 0.f, 0.f};
    const size_t rowbase = (size_t)b * SEQ;
    const int colq = h * 128 + 8 * c8, colf = 2048 + dir * 2048 + h * 128 + 8 * c8;
    const int vrow = 4 * w + tl; const int vch = fr ^ (((vrow & 3) << 2) | ((vrow >> 2) & 3)); const int colv = 6144 + h * 128 + 8 * vch;
#define H2_BAR() do { asm volatile("s_waitcnt lgkmcnt(0)" ::: "memory"); __builtin_amdgcn_s_barrier(); asm volatile("" ::: "memory"); } while (0)
#define H2_TOK(p) (dir ? (SEQ - 1 - (p)) : (p))
#define H2_LOADQF(c) do { _Pragma("unroll") for (int sb_ = 0; sb_ < 2; ++sb_) { const bf16_t* row_ = big + (rowbase + H2_TOK((c) * 64 + 32 * sb_ + et_)) * 10240; qv[sb_] = *(const u32x4*)(row_ + colq); fv[sb_] = *(const u32x4*)(row_ + colf); } } while (0)
#define H2_DMAV(c, buf) do { _Pragma("unroll") for (int sb_ = 0; sb_ < 2; ++sb_) \
        __builtin_amdgcn_global_load_lds((const unsigned*)(big + (rowbase + H2_TOK((c) * 64 + 32 * sb_ + vrow)) * 10240 + colv), (LAS unsigned*)(L + O_VV + (buf) * 16384 + sb_ * 8192 + w * 1024), 16, 0, 0); } while (0)
    u32x4 qv[2], fv[2]; float q8[2][8], f8[2][8], x8[2][8];
#define H2_E1() do { _Pragma("unroll") for (int sb_ = 0; sb_ < 2; ++sb_) { float fz_[8]; const u32x4 fw_ = fv[sb_], qw_ = qv[sb_]; \
        fz_[0] = bf_lo(fw_.x); fz_[1] = bf_hi(fw_.x); fz_[2] = bf_lo(fw_.y); fz_[3] = bf_hi(fw_.y); fz_[4] = bf_lo(fw_.z); fz_[5] = bf_hi(fw_.z); fz_[6] = bf_lo(fw_.w); fz_[7] = bf_hi(fw_.w); \
        q8[sb_][0] = bf_lo(qw_.x); q8[sb_][1] = bf_hi(qw_.x); q8[sb_][2] = bf_lo(qw_.y); q8[sb_][3] = bf_hi(qw_.y); q8[sb_][4] = bf_lo(qw_.z); q8[sb_][5] = bf_hi(qw_.z); q8[sb_][6] = bf_lo(qw_.w); q8[sb_][7] = bf_hi(qw_.w); \
        _Pragma("unroll") for (int k = 0; k < 8; ++k) { f8[sb_][k] = lb8[k] + (1.f - lb8[k]) * sigmoidf_(fz_[k]); x8[sb_][k] = f8[sb_][k]; } \
        _Pragma("unroll") for (int k = 0; k < 8; ++k) { const float y_ = __shfl_up(x8[sb_][k], 16); x8[sb_][k] = (tl >= 1) ? x8[sb_][k] * y_ : x8[sb_][k]; } \
        _Pragma("unroll") for (int k = 0; k < 8; ++k) { const float y_ = __shfl_up(x8[sb_][k], 32); x8[sb_][k] = (tl >= 2) ? x8[sb_][k] * y_ : x8[sb_][k]; } \
        if (tl == 3) { *(LAS f32x4*)(L + O_TOT + sb_ * 4096 + (w * 128 + 8 * c8) * 4) = (f32x4){x8[sb_][0], x8[sb_][1], x8[sb_][2], x8[sb_][3]}; \
                       *(LAS f32x4*)(L + O_TOT + sb_ * 4096 + (w * 128 + 8 * c8 + 4) * 4) = (f32x4){x8[sb_][4], x8[sb_][5], x8[sb_][6], x8[sb_][7]}; } } } while (0)
    H2_LOADQF(0); H2_DMAV(0, 0);
    H2_E1(); asm volatile("s_waitcnt vmcnt(0)" ::: "memory");
    for (int c = 0; c < NIT; ++c) {
        const int buf = c & 1;
        asm volatile("s_waitcnt vmcnt(4)" ::: "memory");
        H2_BAR();
        if (c + 1 < NIT) { H2_LOADQF(c + 1); H2_DMAV(c + 1, buf ^ 1); }
#pragma unroll
        for (int sb = 0; sb < 2; ++sb) {
            __builtin_amdgcn_sched_barrier(0);
            float pre[8], all[8];
            { f32x4 t[8][2];
#pragma unroll
              for (int w2 = 0; w2 < 8; ++w2) { t[w2][0] = *(LAS const f32x4*)(L + O_TOT + sb * 4096 + (w2 * 128 + 8 * c8) * 4); t[w2][1] = *(LAS const f32x4*)(L + O_TOT + sb * 4096 + (w2 * 128 + 8 * c8 + 4) * 4); }
#pragma unroll
              for (int hh = 0; hh < 2; ++hh) {
                  const f32x4 p01 = t[0][hh] * t[1][hh], p23 = t[2][hh] * t[3][hh], p45 = t[4][hh] * t[5][hh], p67 = t[6][hh] * t[7][hh], p03 = p01 * p23, p47 = p45 * p67, pall = p03 * p47;
                  f32x4 pw;
                  if (w == 0) pw = (f32x4){1.f, 1.f, 1.f, 1.f}; else if (w == 1) pw = t[0][hh]; else if (w == 2) pw = p01; else if (w == 3) pw = p01 * t[2][hh];
                  else if (w == 4) pw = p03; else if (w == 5) pw = p03 * t[4][hh]; else if (w == 6) pw = p03 * p45; else pw = p03 * p45 * t[6][hh];
#pragma unroll
                  for (int k = 0; k < 4; ++k) { pre[4 * hh + k] = pw[k]; all[4 * hh + k] = pall[k]; } } }
            float qt[8], kt[8], ks[8];
#pragma unroll
            for (int k = 0; k < 8; ++k) { const float eb = x8[sb][k] * pre[k]; qt[k] = q8[sb][k] * eb; kt[k] = (1.f - f8[sb][k]) * __builtin_amdgcn_rcpf(eb); ks[k] = kt[k] * all[k]; }
            const unsigned o = off_b(32 * sb + et_, c8);
            u32x4 wv; wv.x = cvt_pk_bf16(qt[0], qt[1]); wv.y = cvt_pk_bf16(qt[2], qt[3]); wv.z = cvt_pk_bf16(qt[4], qt[5]); wv.w = cvt_pk_bf16(qt[6], qt[7]); *(LAS u32x4*)(L + O_QT + o) = wv;
            wv.x = cvt_pk_bf16(kt[0], kt[1]); wv.y = cvt_pk_bf16(kt[2], kt[3]); wv.z = cvt_pk_bf16(kt[4], kt[5]); wv.w = cvt_pk_bf16(kt[6], kt[7]); *(LAS u32x4*)(L + O_KT + o) = wv;
            wv.x = cvt_pk_bf16(ks[0], ks[1]); wv.y = cvt_pk_bf16(ks[2], ks[3]); wv.z = cvt_pk_bf16(ks[4], ks[5]); wv.w = cvt_pk_bf16(ks[6], ks[7]); *(LAS u32x4*)(L + O_KS + o) = wv;
            if (tid < 16) { *(LAS f32x4*)(L + O_EBL + sb * 512 + (8 * c8) * 4) = (f32x4){all[0], all[1], all[2], all[3]}; *(LAS f32x4*)(L + O_EBL + sb * 512 + (8 * c8 + 4) * 4) = (f32x4){all[4], all[5], all[6], all[7]}; }
        }
        H2_BAR();
        {
            const int sb = w >> 2, jt = (w >> 1) & 1, it = w & 1; f32x4 a = {0.f, 0.f, 0.f, 0.f};
#pragma unroll
            for (int s4 = 0; s4 < 4; ++s4) { const bf16x8 xk = *(LAS const bf16x8*)(L + O_KT + rr16(lane, 2 * sb + jt, s4)), yq = *(LAS const bf16x8*)(L + O_QT + rr16(lane, 2 * sb + it, s4));
                a = __builtin_amdgcn_mfma_f32_16x16x32_bf16(xk, yq, a, 0, 0, 0); }
            const int ig = 16 * it + fr, jg = 16 * jt + 4 * fq;
#pragma unroll
            for (int r = 0; r < 4; ++r) a[r] = (jg + r <= ig) ? a[r] : 0.f;
            u32x2 v2; v2.x = cvt_pk_bf16(a[0], a[1]); v2.y = cvt_pk_bf16(a[2], a[3]);
            *(LAS u32x2*)(L + O_SS + sb * 2048 + ig * 64 + jg * 2) = v2;
        }
        H2_BAR();
#pragma unroll
        for (int sb = 0; sb < 2; ++sb) {
            __builtin_amdgcn_sched_barrier(0);
            const unsigned vb = lbase + O_VV + buf * 16384 + sb * 8192;
            const s16x4 v0 = tr_rd(vb + tr16(lane, w, 0)), v1 = tr_rd(vb + tr16(lane, w, 1));
            const bf16x8 xv = PK2T(v0, v1);
            f32x4 a[2] = {{0.f, 0.f, 0.f, 0.f}, {0.f, 0.f, 0.f, 0.f}};
#pragma unroll
            for (int ks = 0; ks < 4; ++ks) {
                u32x4 t; t.x = cvt_pk_bf16(S[2 * ks][0], S[2 * ks][1]); t.y = cvt_pk_bf16(S[2 * ks][2], S[2 * ks][3]); t.z = cvt_pk_bf16(S[2 * ks + 1][0], S[2 * ks + 1][1]); t.w = cvt_pk_bf16(S[2 * ks + 1][2], S[2 * ks + 1][3]);
                const bf16x8 xs = *reinterpret_cast<bf16x8*>(&t);
                const int ch = 4 * ks + (fq >> 1);
#pragma unroll
                for (int it = 0; it < 2; ++it) { const int i = 32 * sb + 16 * it + fr;
                    const u32x2 y0 = *(LAS const u32x2*)(L + O_QT + off_b(i, ch) + 8 * (fq & 1)), y1 = *(LAS const u32x2*)(L + O_QT + off_b(i, ch + 2) + 8 * (fq & 1));
                    u32x4 ty = {y0.x, y0.y, y1.x, y1.y};
                    a[it] = __builtin_amdgcn_mfma_f32_16x16x32_bf16(xs, *reinterpret_cast<bf16x8*>(&ty), a[it], 0, 0, 0); }
            }
#pragma unroll
            for (int it = 0; it < 2; ++it) { const int il = 16 * it + fr;
                const bf16x8 ys = *(LAS const bf16x8*)(L + O_SS + sb * 2048 + il * 64 + fq * 16);
                const f32x4 aa = __builtin_amdgcn_mfma_f32_16x16x32_bf16(xv, ys, a[it], 0, 0, 0);
                u32x2 v2; v2.x = cvt_pk_bf16(aa[0], aa[1]); v2.y = cvt_pk_bf16(aa[2], aa[3]);
                *(u32x2*)(outp + (rowbase + H2_TOK(c * 64 + 32 * sb + il)) * 2048 + h * 128 + 16 * w + 4 * fq) = v2; }
            const unsigned kb = lbase + O_KS + sb * 8192;
#pragma unroll
            for (int hb = 0; hb < 2; ++hb) {
                s16x4 ka[4], kc[4]; f32x4 e4[4];
#pragma unroll
                for (int q4 = 0; q4 < 4; ++q4) { const int dt = 4 * hb + q4; ka[q4] = tr_rd(kb + tr16(lane, dt, 0)); kc[q4] = tr_rd(kb + tr16(lane, dt, 1)); e4[q4] = *(LAS const f32x4*)(L + O_EBL + sb * 512 + (16 * dt + 4 * fq) * 4); }
#pragma unroll
                for (int q4 = 0; q4 < 4; ++q4) { const int dt = 4 * hb + q4; S[dt] = __builtin_amdgcn_mfma_f32_16x16x32_bf16(PK2T(ka[q4], kc[q4]), xv, S[dt] * e4[q4], 0, 0, 0); }
            }
        }
        if (c + 1 < NIT) H2_E1();
    }
    asm volatile("s_waitcnt vmcnt(0)" ::: "memory");
    H2_BAR();
#undef H2_BAR
#undef H2_TOK
#undef H2_LOADQF
#undef H2_DMAV
#undef H2_E1
}

__device__ __forceinline__ void ret_scan_item(const Frame& F, const bf16_t* big, bf16_t* O, const float* decay, int b, int h, int sl) {
    constexpr unsigned O_Q = 0, O_K = 49152, O_V = 98304, O_SS = 122880;
    constexpr int NCH = SEQ / 32;
    LAS char* L = (LAS char*)F.lds;
    int tid = F.tid; asm volatile("" : "+v"(tid));
    const int lane = tid & 63, w = __builtin_amdgcn_readfirstlane(tid >> 6), fq = lane >> 4, fr = lane & 15, tl = fq;
    const unsigned lbase = (unsigned)(uintptr_t)L;
    const size_t rowbase = (size_t)b * SEQ;
    const int drow = 4 * w + tl, dch = fr ^ (((drow & 3) << 2) | ((drow >> 2) & 3));
    const int qcol = h * 256 + 8 * dch, kcol = 2048 + h * 256 + 8 * dch, vcol = 4096 + h * 512 + sl * 128 + 8 * dch;
    const int ocol = h * 512 + sl * 128 + 16 * w + 4 * fq;
#define RT_BAR() do { asm volatile("s_waitcnt lgkmcnt(0)" ::: "memory"); __builtin_amdgcn_s_barrier(); asm volatile("" ::: "memory"); } while (0)
#pragma unroll 1
    for (int dir = 0; dir < 2; ++dir) {
        const float lg2 = -log1pf(expf(-decay[dir * 8 + h])) * 1.4426950408889634f;
        const float g32 = exp2f(lg2 * 32.f), ig32 = exp2f(-lg2 * 32.f);
        float sc = 1.f, isc = ig32;
        float gq[2], kdec[8], wdec[4];
        gq[0] = exp2f(lg2 * (float)(fr + 1)); gq[1] = exp2f(lg2 * (float)(fr + 17));
#pragma unroll
        for (int k = 0; k < 8; ++k) kdec[k] = exp2f(lg2 * (float)(31 - (8 * fq + 4 * (k >> 2) + (k & 3))));
        const int jt = w >> 1, it1 = w & 1, ig = 16 * it1 + fr, jg = 16 * jt + 4 * fq;
#pragma unroll
        for (int r = 0; r < 4; ++r) wdec[r] = (jg + r <= ig) ? exp2f(lg2 * (float)(ig - jg - r)) : 0.f;
        f32x4 S[16];
#pragma unroll
        for (int i = 0; i < 16; ++i) S[i] = (f32x4){0.f, 0.f, 0.f, 0.f};
#define RT_TOK(p) (dir ? (SEQ - 1 - (p)) : (p))
#define RT_DMA(c, buf) do { const bf16_t* src_ = big + (rowbase + RT_TOK((c) * 32 + drow)) * 12288; \
        __builtin_amdgcn_global_load_lds((const unsigned*)(src_ + qcol), (LAS unsigned*)(L + O_Q + (buf) * 16384 + w * 1024), 16, 0, 0); \
        __builtin_amdgcn_global_load_lds((const unsigned*)(src_ + qcol + 128), (LAS unsigned*)(L + O_Q + (buf) * 16384 + 8192 + w * 1024), 16, 0, 0); \
        __builtin_amdgcn_global_load_lds((const unsigned*)(src_ + kcol), (LAS unsigned*)(L + O_K + (buf) * 16384 + w * 1024), 16, 0, 0); \
        __builtin_amdgcn_global_load_lds((const unsigned*)(src_ + kcol + 128), (LAS unsigned*)(L + O_K + (buf) * 16384 + 8192 + w * 1024), 16, 0, 0); \
        __builtin_amdgcn_global_load_lds((const unsigned*)(src_ + vcol), (LAS unsigned*)(L + O_V + (buf) * 8192 + w * 1024), 16, 0, 0); } while (0)
        RT_DMA(0, 0); RT_DMA(1, 1); asm volatile("s_waitcnt vmcnt(5)" ::: "memory");
        int buf = 0;
        for (int c = 0; c < NCH; ++c) {
            const int sb = c & 1;
            if (c + 1 < NCH) asm volatile("s_waitcnt vmcnt(7)" ::: "memory");
            else asm volatile("s_waitcnt vmcnt(0)" ::: "memory");
            RT_BAR();
            { const int nb = buf == 0 ? 2 : buf - 1;
              if (c + 2 < NCH) RT_DMA(c + 2, nb); }
            if (w < 4 && w != 2) {
                f32x4 a = {0.f, 0.f, 0.f, 0.f};
#pragma unroll
                for (int sub = 0; sub < 2; ++sub)
#pragma unroll
                    for (int s4 = 0; s4 < 4; ++s4) { const bf16x8 xk = *(LAS const bf16x8*)(L + O_K + buf * 16384 + sub * 8192 + rr16(lane, jt, s4)), yq = *(LAS const bf16x8*)(L + O_Q + buf * 16384 + sub * 8192 + rr16(lane, it1, s4));
                        a = __builtin_amdgcn_mfma_f32_16x16x32_bf16(xk, yq, a, 0, 0, 0); }
                u32x2 v2; v2.x = cvt_pk_bf16(a[0] * wdec[0], a[1] * wdec[1]); v2.y = cvt_pk_bf16(a[2] * wdec[2], a[3] * wdec[3]);
                *(LAS u32x2*)(L + O_SS + sb * 2048 + ig * 64 + jg * 2) = v2;
            }
            if (w == 2) { *(LAS u32x2*)(L + O_SS + sb * 2048 + (0 + fr) * 64 + (16 + 4 * fq) * 2) = (u32x2){0u, 0u}; }
            RT_BAR();
            {
                const unsigned vb = lbase + O_V + buf * 8192;
                const s16x4 v0 = tr_rd(vb + tr16(lane, w, 0)), v1 = tr_rd(vb + tr16(lane, w, 1));
                const bf16x8 xv = PK2T(v0, v1);
                f32x4 a[2] = {{0.f, 0.f, 0.f, 0.f}, {0.f, 0.f, 0.f, 0.f}};
                {
                    u32x2 yq[2][2][2][2];
#define RT_QRD(kp, slot) do { _Pragma("unroll") for (int k2 = 0; k2 < 2; ++k2) { const int ks_ = 2 * (kp) + k2; const unsigned qb_ = O_Q + buf * 16384 + (ks_ >> 2) * 8192; const int ch_ = 4 * (ks_ & 3) + (fq >> 1); \
                        _Pragma("unroll") for (int it = 0; it < 2; ++it) { const int i_ = 16 * it + fr; \
                            yq[slot][k2][it][0] = *(LAS const u32x2*)(L + qb_ + off_b(i_, ch_) + 8 * (fq & 1)); yq[slot][k2][it][1] = *(LAS const u32x2*)(L + qb_ + off_b(i_, ch_ + 2) + 8 * (fq & 1)); } } } while (0)
                    RT_QRD(0, 0);
#pragma unroll
                    for (int kp = 0; kp < 4; ++kp) {
                        __builtin_amdgcn_sched_barrier(0);
                        if (kp < 3) { if (kp & 1) RT_QRD(kp + 1, 0); else RT_QRD(kp + 1, 1); }
                        __builtin_amdgcn_sched_barrier(0);
#pragma unroll
                        for (int k2 = 0; k2 < 2; ++k2) { const int ks = 2 * kp + k2;
                            u32x4 t; t.x = cvt_pk_bf16(S[2 * ks][0], S[2 * ks][1]); t.y = cvt_pk_bf16(S[2 * ks][2], S[2 * ks][3]); t.z = cvt_pk_bf16(S[2 * ks + 1][0], S[2 * ks + 1][1]); t.w = cvt_pk_bf16(S[2 * ks + 1][2], S[2 * ks + 1][3]);
                            const bf16x8 xs = *reinterpret_cast<bf16x8*>(&t);
#pragma unroll
                            for (int it = 0; it < 2; ++it) { u32x4 ty = {yq[kp & 1][k2][it][0].x, yq[kp & 1][k2][it][0].y, yq[kp & 1][k2][it][1].x, yq[kp & 1][k2][it][1].y};
                                a[it] = __builtin_amdgcn_mfma_f32_16x16x32_bf16(xs, *reinterpret_cast<bf16x8*>(&ty), a[it], 0, 0, 0); } }
                    }
#undef RT_QRD
                }
                __builtin_amdgcn_sched_barrier(0);
#pragma unroll
                for (int it = 0; it < 2; ++it) { const int i = 16 * it + fr;
                    f32x4 aa = a[it] * (gq[it] * sc);
                    const bf16x8 ys = *(LAS const bf16x8*)(L + O_SS + sb * 2048 + i * 64 + fq * 16);
                    aa = __builtin_amdgcn_mfma_f32_16x16x32_bf16(xv, ys, aa, 0, 0, 0);
                    bf16_t* op = O + (rowbase + RT_TOK(c * 32 + i)) * 4096 + ocol;
                    if (dir) { const u32x2 pv = *(const u32x2*)op; aa[0] += bf_lo(pv.x); aa[1] += bf_hi(pv.x); aa[2] += bf_lo(pv.y); aa[3] += bf_hi(pv.y); }
                    u32x2 v2; v2.x = cvt_pk_bf16(aa[0], aa[1]); v2.y = cvt_pk_bf16(aa[2], aa[3]);
                    *(u32x2*)op = v2;
                }
                u32x4 yv;
                { float f0[8];
#pragma unroll
                  for (int k = 0; k < 4; ++k) { f0[k] = __uint_as_float(((unsigned)(unsigned short)v0[k]) << 16) * (kdec[k] * isc); f0[4 + k] = __uint_as_float(((unsigned)(unsigned short)v1[k]) << 16) * (kdec[4 + k] * isc); }
                  yv.x = cvt_pk_bf16(f0[0], f0[1]); yv.y = cvt_pk_bf16(f0[2], f0[3]); yv.z = cvt_pk_bf16(f0[4], f0[5]); yv.w = cvt_pk_bf16(f0[6], f0[7]); }
                const bf16x8 yvb = *reinterpret_cast<bf16x8*>(&yv);
                {
                    s16x4 ka[2][4], kc[2][4];
#define RT_KRD(bt, slot) do { _Pragma("unroll") for (int q4 = 0; q4 < 4; ++q4) { const int dt_ = 4 * (bt) + q4; const unsigned kb_ = lbase + O_K + buf * 16384 + (dt_ >> 3) * 8192; \
                        ka[slot][q4] = tr_rd(kb_ + tr16(lane, dt_ & 7, 0)); kc[slot][q4] = tr_rd(kb_ + tr16(lane, dt_ & 7, 1)); } } while (0)
                    RT_KRD(0, 0);
#pragma unroll
                    for (int bt = 0; bt < 4; ++bt) {
                        __builtin_amdgcn_sched_barrier(0);
                        if (bt < 3) { if (bt & 1) RT_KRD(bt + 1, 0); else RT_KRD(bt + 1, 1); }
                        __builtin_amdgcn_sched_barrier(0);
#pragma unroll
                        for (int q4 = 0; q4 < 4; ++q4) { const int dt = 4 * bt + q4; S[dt] = __builtin_amdgcn_mfma_f32_16x16x32_bf16(PK2T(ka[bt & 1][q4], kc[bt & 1][q4]), yvb, S[dt], 0, 0, 0); }
                    }
#undef RT_KRD
                }
            }
            buf = (buf == 2) ? 0 : buf + 1; sc *= g32; isc *= ig32;
        }
        asm volatile("s_waitcnt vmcnt(0)" ::: "memory");
        RT_BAR();
    }
#undef RT_TOK
#undef RT_DMA
#undef RT_BAR
}

#define MIX_END_BAR() do { if (g == NGROUP - 1) GRID_BAR(); else { __syncthreads(); F = make_frame(lds); nth = (long)F.G * NTHREADS; gtid0 = (long)F.bid * NTHREADS + F.tid; } } while (0)
#define GRID_BAR() do { for (int rb_ = 0; rb_ < REP_BAR; ++rb_) xcd_barrier(bar); F = make_frame(lds); nth = (long)F.G * NTHREADS; gtid0 = (long)F.bid * NTHREADS + F.tid; } while (0)

#define WL ((bf16_t*)(PWS + WS_WL))
#define Hb ((bf16_t*)(PWS + WS_H))
#define QM ((bf16_t*)(PWS + WS_QM))
#define OM ((bf16_t*)(PWS + WS_OM))
#define OB ((bf16_t*)(PWS + WS_OB))
#define BIG ((bf16_t*)(PWS + WS_BIG))
#define MN ((bf16_t*)(PWS + WS_MN))
#define MEMKV ((bf16_t*)(PWS + WS_MEMKV))
#define tab_rc ((const float*)(PWS + WS_TAB + TAB_RC))
#define tab_rs ((const float*)(PWS + WS_TAB + TAB_RS))
#define tab_mc ((const float*)(PWS + WS_TAB + TAB_MC))
#define tab_ms ((const float*)(PWS + WS_TAB + TAB_MS))
#define XBg ((bf16_t*)(PWS + WS_XB) + (size_t)g * T * DM)
#define SSQg ((float*)(PWS + WS_SSQ) + (size_t)g * T * 8)
#define EPITAB ((LAS float*)(F.lds + EPI_TAB_OFF))
template <int L>
__device__ __forceinline__ void layer_body(LAS unsigned char* lds, const XcdBarrier& bar) {
    { Frame F = make_frame(lds);
    long nth = (long)F.G * NTHREADS, gtid0 = (long)F.bid * NTHREADS + F.tid;

    convert_mat(F, PIN(I_MEM_WQ) + (size_t)L * 2048 * 512, 2048, 512, WL + W_MEMQ, PIN(I_NMEM) + L * DM);
    convert_mat(F, PIN(I_MEM_WKV) + (size_t)L * 2048 * 1024, 2048, 1024, WL + W_MEMKV, PIN(I_NMEMTOK) + L * DM);
    convert_mat(F, PIN(I_MEM_WOUT) + (size_t)L * 512 * 2048, 512, 2048, WL + W_MEMOUT);
    convert_mat(F, PIN(I_MLP_W1) + (size_t)L * 2048 * 8192, 2048, 8192, WL + W_1, PIN(I_NMLP) + L * DM);
    convert_mat(F, PIN(I_MLP_W2) + (size_t)L * 8192 * 2048, 8192, 2048, WL + W_2);
    if constexpr (L == 0) { convert_mat(F, PIN(I_RET_WIN), 2048, 12288, WL + W_IN, PIN(I_NMIX) + L * DM); convert_mat(F, PIN(I_RET_WOUT), 4096, 2048, WL + W_OUT); }
    if constexpr (L == 1) { convert_mat(F, PIN(I_HG_WIN), 2048, 10240, WL + W_IN, PIN(I_NMIX) + L * DM); convert_mat(F, PIN(I_HG_WOUT), 2048, 2048, WL + W_OUT); }
    if constexpr (L == 2) { convert_mat(F, PIN(I_MLA_WIN), 2048, 1088, WL + W_IN, PIN(I_NMIX) + L * DM); convert_mat(F, PIN(I_MLA_WOUT), 2048, 2048, WL + W_OUT);
        convert_mat(F, PIN(I_MLA_WQB), 512, 3072, WL + W_QB, PIN(I_MLA_QNORM)); convert_mat(F, PIN(I_MLA_WKVB), 512, 4096, WL + W_KVB, PIN(I_MLA_KVNORM));
        for (long i = gtid0; i < (long)(1280 - 1088) * 2048 / 8; i += nth) ((u32x4*)(WL + W_IN + (size_t)1088 * 2048))[i] = (u32x4){0u, 0u, 0u, 0u}; }
    if constexpr (L == 3) { convert_mat(F, PIN(I_GQA_WIN), 2048, 3072, WL + W_IN, PIN(I_NMIX) + L * DM); convert_mat(F, PIN(I_GQA_WOUT), 2048, 2048, WL + W_OUT); }
    if constexpr (L == 0) { xcopy_rows(F, PIN(I_XP), (bf16_t*)(PWS + WS_XB), (float*)(PWS + WS_SSQ), T); xcopy_rows(F, PIN(I_XS), (bf16_t*)(PWS + WS_XB) + (size_t)T * DM, (float*)(PWS + WS_SSQ) + (size_t)T * 8, 2 * T); }
    if constexpr (L == 0) {
        norm_rows(F, PIN(I_MP), nullptr, MN, 8 * MEMT);
        norm_rows(F, PIN(I_MS), nullptr, MN + (size_t)8 * MEMT * DM, 16 * MEMT); }
    GRID_BAR();
    if constexpr (L == 2) {
        pg8::Gemm gm{(bf16_t*)(PWS + WS_XB), WL + W_IN, 3 * T, 1280, 2048}; pg8::StaticOrder S; S.init(3 * T, 1280, F.G, F.bid, WGM_IN);
        pg8::EpiBf16<0, true, -1, true> E{(bf16_t*)(PWS + WS_BIG + MLA_C), 1280, (float*)(PWS + WS_SSQ), (float*)(PWS + WS_BIG + MLA_CQ), (LAS float*)(F.lds + EPI_TAB_OFF)};
        pg8::gemm_phase(F.lds, gm, S, E);
        GRID_BAR();
    }
    }

#pragma unroll 1
    for (int g = 0; g < NGROUP; ++g) {
        Frame F = make_frame(lds);
        long nth = (long)F.G * NTHREADS, gtid0 = (long)F.bid * NTHREADS + F.tid;
#define xo (POUT + (size_t)g * T * DM)
#define xin0 ((g == 0) ? PIN(I_XP) : PIN(I_XS) + (size_t)(g - 1) * T * DM)
#define xcur ((L == 0) ? xin0 : (const float*)xo)

        if constexpr (L == 0) {
            { pg8::Gemm gm{XBg, WL + W_IN, T, 12288, 2048}; pg8::StaticOrder S; S.init(T, 12288, F.G, F.bid, WGM_IN); pg8::EpiRetIn E{BIG, 12288, SSQg, tab_rc, tab_rs}; for (int rep = 0; rep < REP_GEMMBF; ++rep) pg8::gemm_phase(F.lds, gm, S, E); }
            GRID_BAR();
            for (int rep = 0; rep < REP_RET; ++rep) for (int u = (F.bid % 8) * (F.G / 8) + F.bid / 8  ; u < GSEQ * 8 * 4; u += F.G) { const int sl = u & 3, hh = (u >> 2) & 7, bb = u >> 5; ret_scan_item(F, BIG, OB, PIN(I_RET_DECAY), bb, hh, sl); }
            GRID_BAR();
            combine_rows<32>(F, OB, 4096, nullptr, BIG + 8192, 12288, PIN(I_RET_ONORM), OB, 4096, 8, (long)T * 8);
            GRID_BAR();
            { pg8::Gemm gm{OB, WL + W_OUT, T, 2048, 4096}; pg8::StaticOrder S; S.init(T, 2048, F.G, F.bid, WGM_RES); pg8::EpiResidX<false> E{XBg, SSQg, EPITAB, nullptr}; pg8::gemm_phase(F.lds, gm, S, E); }
            MIX_END_BAR();
        }
        if constexpr (L == 1) {
            { pg8::Gemm gm{XBg, WL + W_IN, T, 10240, 2048}; pg8::StaticOrder S; S.init(T, 10240, F.G, F.bid, WGM_IN); pg8::EpiBf16<0, true> E{BIG, 10240, SSQg}; for (int rep = 0; rep < REP_GEMMBF; ++rep) pg8::gemm_phase(F.lds, gm, S, E); }
            GRID_BAR();
            for (int rep = 0; rep < REP_HG; ++rep) for (int u = (F.bid % 8) * (F.G / 8) + F.bid / 8  ; u < GSEQ * 16 * 2; u += F.G) { const int dir = u & 1, h = (u >> 1) & 15, b = u >> 5;
                hg_scan2_item(F, BIG, PIN(I_HG_LB), OB + (size_t)dir * T * 2048, b, h, dir); }
            GRID_BAR();
            combine_rows<8>(F, OB, 2048, OB + (size_t)T * 2048, BIG + 8192, 10240, PIN(I_HG_ONORM), Hb, 2048, 16, (long)T * 16);
            GRID_BAR();
            { pg8::Gemm gm{Hb, WL + W_OUT, T, 2048, 2048}; pg8::StaticOrder S; S.init(T, 2048, F.G, F.bid, WGM_RES); pg8::EpiResidX<false> E{XBg, SSQg, EPITAB, nullptr}; pg8::gemm_phase(F.lds, gm, S, E); }
            MIX_END_BAR();
        }
        if constexpr (L == 2) {
#define Cb ((bf16_t*)(PWS + WS_BIG + MLA_C) + (size_t)g * T * 1280)
#define SS2g ((float*)(PWS + WS_BIG + MLA_CQ) + (size_t)g * T * 8)
#define Qb ((bf16_t*)(PWS + WS_BIG + MLA_Q))
#define KV ((bf16_t*)(PWS + WS_BIG + MLA_KV))
#define KK ((bf16_t*)(PWS + WS_H))
            { pg8::Gemm gm{Cb, WL + W_QB, T, 3072, 512, 1280}; pg8::StaticOrder S; S.init(T, 3072, F.G, F.bid, WGM_IN); pg8::EpiBf16<0, true, 0> E{Qb, 3072, SS2g}; for (int rep = 0; rep < REP_GEMMBF; ++rep) pg8::gemm_phase(F.lds, gm, S, E); }
            { pg8::Gemm gm{Cb + 512, WL + W_KVB, T, 4096, 512, 1280}; pg8::StaticOrder S; S.init(T, 4096, F.G, F.bid); pg8::EpiBf16<0, true, 2> E{KV, 4096, SS2g}; for (int rep = 0; rep < REP_GEMMBF; ++rep) pg8::gemm_phase(F.lds, gm, S, E); }
            GRID_BAR();
            { bf16_t* qb_ = Qb; bf16_t* kk_ = KK; const bf16_t* cb = Cb; const bf16_t* kv_ = KV; const float* gnb = PIN(I_MLA_QKNORM); const float* tmc = tab_mc; const float* tms = tab_ms;
              post_loop<16, true, 4>(gtid0, nth, (long)T * 16 * 16, 1.f / 192.f, [=](long gt) { const long hv = gt >> 4; const int j = (int)(gt & 15); const long t = hv >> 4; const int hh = 16 + (int)(hv & 15);
                const int pos = (int)(t & (SEQ - 1)); const bool isk = hh >= 16; const int h = hh & 15; const bool act = j < 12, rp = j >= 8;
                const int e1 = rp ? 128 + 8 * (j - 8) : 16 * j, e2 = rp ? e1 + 32 : e1 + 8;
                const bf16_t *s1, *s2; bf16_t *d1, *d2;
                if (!isk) { bf16_t* p = qb_ + t * 3072 + h * 192; s1 = p + e1; s2 = p + e2; d1 = p + e1; d2 = p + e2; }
                else { bf16_t* p = kk_ + t * 3072 + h * 192; d1 = p + e1; d2 = p + e2;
                       if (rp) { s1 = cb + t * 1280 + 1024 + (e1 - 128); s2 = s1 + 32; } else { s1 = kv_ + t * 4096 + h * 256 + e1; s2 = s1 + 8; } }
                const float* gn = gnb + (isk ? 192 : 0); const int ti = rp ? 8 * (j - 8) : 0;
                return PItem{s1, s2, d1, d2, gn + e1, gn + e2, tmc + pos * 32 + ti, tms + pos * 32 + ti, 1.f, rp, act}; }); }
            GRID_BAR();
            for (int rep = 0; rep < REP_ATTN; ++rep) attn_phase<192, 0, 3>(F, Qb, 3072, 192, KK, 3072, 192, KV + 128, 4096, 256, OB, 2048, 128, GSEQ, 16, 1, 1, SEQ, SEQ, 0.07216878364870322f * 1.4426950408889634f, nullptr, PIN(I_MLA_QKNORM), tab_mc, tab_ms);
            GRID_BAR();
            { pg8::Gemm gm{OB, WL + W_OUT, T, 2048, 2048}; pg8::StaticOrder S; S.init(T, 2048, F.G, F.bid, WGM_RES); pg8::EpiResidX<false> E{XBg, SSQg, EPITAB, nullptr}; pg8::gemm_phase(F.lds, gm, S, E); }
            MIX_END_BAR();
        }
        if constexpr (L == 3) {
            { pg8::Gemm gm{XBg, WL + W_IN, T, 3072, 2048}; pg8::StaticOrder S; S.init(T, 3072, F.G, F.bid, WGM_IN); pg8::EpiBf16<0, true> E{BIG, 3072, SSQg}; for (int rep = 0; rep < REP_GEMMBF; ++rep) pg8::gemm_phase(F.lds, gm, S, E); }
            GRID_BAR();
            { bf16_t* bg = BIG; const float* gnb = PIN(I_GQA_QKNORM); const float* tmc = tab_mc; const float* tms = tab_ms;
              post_loop<8, true, 4>(gtid0, nth, (long)T * 4 * 8, 1.f / 128.f, [=](long gt) { const long hv = gt >> 3; const int j = (int)(gt & 7); const long t = hv >> 2; const int hh = 16 + (int)(hv & 3);
                const int tp = (int)(t & (SEQ - 1)); const int seg = j >> 2; const int pos = seg ? (tp & 63) : (tp >> 6);
                const int e1 = seg * 64 + 8 * (j & 3), e2 = e1 + 32; bf16_t* p = bg + t * 3072 + hh * 128; const float* gn = gnb + (hh >= 16 ? 128 : 0);
                return PItem{p + e1, p + e2, p + e1, p + e2, gn + e1, gn + e2, tmc + pos * 32 + 8 * (j & 3), tms + pos * 32 + 8 * (j & 3), 1.f, true, true}; }); }
            GRID_BAR();
            for (int rep = 0; rep < REP_ATTN; ++rep) attn_phase<128, 0, 2>(F, BIG, 3072, 128, BIG + 2048, 3072, 128, BIG + 2560, 3072, 128, OB, 2048, 128, GSEQ, 16, 4, 1, SEQ, SEQ, 0.08838834764831845f * 1.4426950408889634f, nullptr, PIN(I_GQA_QKNORM), tab_mc, tab_ms);
            GRID_BAR();
            { pg8::Gemm gm{OB, WL + W_OUT, T, 2048, 2048}; pg8::StaticOrder S; S.init(T, 2048, F.G, F.bid, WGM_RES); pg8::EpiResidX<false> E{XBg, SSQg, EPITAB, nullptr}; pg8::gemm_phase(F.lds, gm, S, E); }
            MIX_END_BAR();
        }

    }
    {
        Frame F = make_frame(lds);
        long nth = (long)F.G * NTHREADS, gtid0 = (long)F.bid * NTHREADS + F.tid;
#define XBall ((bf16_t*)(PWS + WS_XB))
#define SSQall ((float*)(PWS + WS_SSQ))
#define QMall ((bf16_t*)(PWS + WS_H))
#define OMall ((bf16_t*)(PWS + WS_H + 48 * MiB))
        { pg8::Gemm gm{XBall, WL + W_MEMQ, 3 * T, 512, 2048}; pg8::StaticOrder S; S.init(3 * T, 512, F.G, F.bid); pg8::EpiBf16<0, true> E{QMall, 512, SSQall}; for (int rep = 0; rep < REP_GEMMBF; ++rep) pg8::gemm_phase(F.lds, gm, S, E); }
        { pg8::Gemm gm{MN, WL + W_MEMKV, MROWS, 1024, 2048}; pg8::StaticOrder S; S.init(MROWS, 1024, F.G, (F.bid + F.G / 2) % F.G);
          pg8::EpiBf16<0> E{MEMKV, 1024, nullptr}; for (int rep = 0; rep < REP_GEMMBF; ++rep) pg8::gemm_phase(F.lds, gm, S, E); }
        GRID_BAR();
        { const float* gk = PIN(I_MEM_QKNORM) + L * 256 + 128; bf16_t* mkv = MEMKV;
          post_loop<8, true, 4>(gtid0, nth, (long)MROWS * 4 * 8, 1.f / 128.f, [=](long gt) { const long hv = gt >> 3; const int j = (int)(gt & 7); const long row = hv >> 2; const int h = (int)(hv & 3);
              const int e1 = (j >> 2) * 64 + 8 * (j & 3), e2 = e1 + 32; bf16_t* p = mkv + row * 1024 + h * 128;
              return PItem{p + e1, p + e2, p + e1, p + e2, gk + e1, gk + e2, nullptr, nullptr, 1.f, false, true}; }); }
        GRID_BAR();
        for (int rep = 0; rep < REP_ATTN; ++rep) attn_phase<128, 0, 1>(F, QMall, 512, 128, MEMKV, 1024, 128, MEMKV + 512, 1024, 128, OMall, 512, 128, NBATCH, 4, 1, 1, SEQ, MEMT,
                           0.08838834764831845f * 1.4426950408889634f, nullptr, PIN(I_MEM_QKNORM) + L * 256, nullptr, nullptr);
        GRID_BAR();
        { pg8::Gemm gm{OMall, WL + W_MEMOUT, 3 * T, 2048, 512}; pg8::StaticOrder S; S.init(3 * T, 2048, F.G, F.bid, WGM_RES); pg8::EpiResidX<false> E{XBall, SSQall, EPITAB, nullptr}; pg8::gemm_phase(F.lds, gm, S, E); }
        GRID_BAR();
    }
#pragma unroll 1
    for (int g = 0; g < MLP_NG; ++g) {
        Frame F = make_frame(lds);
        long nth = (long)F.G * NTHREADS, gtid0 = (long)F.bid * NTHREADS + F.tid; (void)nth; (void)gtid0;
#define XBm ((bf16_t*)(PWS + WS_XB) + (size_t)g * MLP_T * DM)
#define SSQm ((float*)(PWS + WS_SSQ) + (size_t)g * MLP_T * 8)
#define HIDm (BIG + (size_t)(g & 1) * MLP_T * 8192)
        { pg8::Gemm gm{XBm, WL + W_1, MLP_T, 8192, 2048}; pg8::StaticOrder S; S.init(MLP_T, 8192, F.G, F.bid, WGM_MLP1); pg8::EpiBf16<1, true> E{HIDm, 8192, SSQm}; for (int rep = 0; rep < REP_GEMMBF; ++rep) pg8::gemm_phase(F.lds, gm, S, E); }
        GRID_BAR();
        { pg8::Gemm gm{HIDm, WL + W_2, MLP_T, 2048, 8192}; pg8::StaticOrder S; S.init(MLP_T, 2048, F.G, F.bid, WGM_RES); pg8::EpiResidX<L == 3> E{XBm, SSQm, EPITAB, POUT + (size_t)g * MLP_T * DM}; pg8::gemm_phase(F.lds, gm, S, E); }
        if (g == MLP_NG - 1) GRID_BAR();
        else { __syncthreads(); F = make_frame(lds); nth = (long)F.G * NTHREADS; gtid0 = (long)F.bid * NTHREADS + F.tid; }
    }
}

__global__ void __launch_bounds__(NTHREADS, 2) fwd(Params P) {
    extern __shared__ __attribute__((aligned(16))) unsigned char lds_raw[];
    LAS unsigned char* lds = (LAS unsigned char*)lds_raw;
    volatile LAS unsigned* MISC = (volatile LAS unsigned*)(lds + MISC_OFF);
    if (threadIdx.x < 16) MISC[threadIdx.x] = 0u;
    __syncthreads();
    XcdBarrier bar = xcd_barrier_post((unsigned*)(PWS + WS_CTL), MISC + 8);

    { unsigned char* ws = PWS; float* rc = (float*)(ws + WS_TAB + TAB_RC); float* rs = (float*)(ws + WS_TAB + TAB_RS); float* mc = (float*)(ws + WS_TAB + TAB_MC); float* ms = (float*)(ws + WS_TAB + TAB_MS);
      const long nth = (long)gridDim.x * NTHREADS;
      for (long i = (long)blockIdx.x * NTHREADS + threadIdx.x; i < (long)SEQ * 128; i += nth) { const int pos = (int)(i >> 7), k = (int)(i & 127);
          const float fr = powf(10000.f, -(float)k / 128.f); const float ang = (float)pos * fr; rc[i] = cosf(ang); rs[i] = sinf(ang); }
      for (long i = (long)blockIdx.x * NTHREADS + threadIdx.x; i < (long)SEQ * 32; i += nth) { const int pos = (int)(i >> 5), k = (int)(i & 31);
          const float fr = powf(10000.f, -(float)k / 32.f); const float ang = (float)pos * fr; mc[i] = cosf(ang); ms[i] = sinf(ang); } }

#ifndef ONLY_L
    layer_body<0>(lds, bar);
    layer_body<1>(lds, bar);
    layer_body<2>(lds, bar);
    layer_body<3>(lds, bar);
#else
    layer_body<ONLY_L>(lds, bar);
#endif
}

extern "C" void kernel_launch(void* const* d_in, const int* in_sizes, int n_in, void* d_out, int out_size, void* d_ws, size_t ws_size, hipStream_t stream) {
    static int grid = 0;
    if (grid == 0) {
        if (n_in != 32 || out_size != NBATCH * SEQ * DM || ws_size < WS_END) { fprintf(stderr, "kernel_launch: unexpected shapes: n_in %d out %d ws %zu (need %zu)\n", n_in, out_size, ws_size, (size_t)WS_END); grid = -1; return; }
        int dev = 0, cus = 0;
        if (hipGetDevice(&dev) != hipSuccess || hipDeviceGetAttribute(&cus, hipDeviceAttributeMultiprocessorCount, dev) != hipSuccess) { grid = -1; return; }
        if (hipFuncSetAttribute((const void*)fwd, hipFuncAttributeMaxDynamicSharedMemorySize, LDS_BYTES) != hipSuccess) { fprintf(stderr, "kernel_launch: hipFuncSetAttribute failed\n"); grid = -1; return; }
        int per_cu = 0;
        if (hipOccupancyMaxActiveBlocksPerMultiprocessor(&per_cu, (const void*)fwd, NTHREADS, LDS_BYTES) != hipSuccess || per_cu < 1) fprintf(stderr, "kernel_launch: occupancy query says %d\n", per_cu);
        (void)hipGetLastError();
        grid = cus;
    }
    if (grid < 0) return;
    (void)hipMemsetAsync((char*)d_ws + WS_CTL, 0, XCD_BAR_WORDS * sizeof(unsigned), stream);
    Params p{};
    for (int i = 0; i < 32; ++i) p.in[i] = (const float*)d_in[i];
    p.out = (float*)d_out; p.ws = (unsigned char*)d_ws;
    hipLaunchKernelGGL(fwd, dim3(grid), dim3(NTHREADS), LDS_BYTES, stream, p);
    const hipError_t le = hipPeekAtLastError();
    if (le != hipSuccess) fprintf(stderr, "kernel_launch: launch failed: %s\n", hipGetErrorName(le));
}
```
